# Optimizing an MI355X kernel written in HIP

```python
import math
import jax, jax.numpy as jnp
from jax import lax
import numpy as np

D_MODEL = 2048
BATCH = 4
SEQ = 4096
DEPTH = 1

S5_WIDTH = D_MODEL // 2
S5_GROUP = 16
S5_GROUPS = S5_WIDTH // S5_GROUP
S5_STATE = 64
DT_MIN = 1e-3
DT_MAX = 1e-1
S5_MAX_RE = -1e-4
HGRN_WIDTH = D_MODEL // 2
HGRN_EXPAND = 128
HGRN_HEADS = HGRN_WIDTH // HGRN_EXPAND
HGRN_HEAD_DIM = HGRN_EXPAND
HGRN_CHUNK = 64
D_FF = 5632
CONV_WIDTH = 3
RMS_EPS = 1e-6
N_IN = S5_WIDTH + 4 * HGRN_WIDTH + 2 * D_MODEL

kernel_name = 'hybrid_s5_hgrn2_gated_merge_block'


def _rmsnorm(x, g):
    xf = x.astype(jnp.float32)
    y = xf * lax.rsqrt(jnp.mean(xf * xf, axis=-1, keepdims=True) + RMS_EPS)
    return (y * g.astype(jnp.float32)).astype(x.dtype)


def _in_splits():
    sizes = [S5_WIDTH, HGRN_WIDTH, HGRN_WIDTH, HGRN_WIDTH, HGRN_WIDTH, D_MODEL, D_MODEL]
    offs, acc = [], 0
    for s in sizes[:-1]:
        acc += s
        offs.append(acc)
    return offs


def _complex_affine_combine(first, second):
    a1r, a1i, b1r, b1i = first
    a2r, a2i, b2r, b2i = second
    return (a2r * a1r - a2i * a1i,
            a2r * a1i + a2i * a1r,
            a2r * b1r - a2i * b1i + b2r,
            a2r * b1i + a2i * b1r + b2i)


def _s5_branch(u, a_re, a_im, log_dt, b_re, b_im, c_re, c_im, d, w_glu, b_glu):
    bsz, L, _ = u.shape
    f32 = jnp.float32
    uf = u.astype(f32).reshape(bsz, L, S5_GROUPS, S5_GROUP)
    lam_re = jnp.minimum(a_re.astype(f32), S5_MAX_RE)
    lam_im = a_im.astype(f32)
    dt = jnp.exp(log_dt.astype(f32))[:, None]
    mag = jnp.exp(lam_re * dt)
    abar_re = mag * jnp.cos(lam_im * dt)
    abar_im = mag * jnp.sin(lam_im * dt)
    den = lam_re * lam_re + lam_im * lam_im
    nr = abar_re - 1.0
    ni = abar_im
    coef_re = (nr * lam_re + ni * lam_im) / den
    coef_im = (ni * lam_re - nr * lam_im) / den
    bu_re = jnp.einsum('blgc,gpc->blgp', uf, b_re.astype(f32))
    bu_im = jnp.einsum('blgc,gpc->blgp', uf, b_im.astype(f32))
    bb_re = coef_re * bu_re - coef_im * bu_im
    bb_im = coef_re * bu_im + coef_im * bu_re
    a_seq_re = jnp.broadcast_to(abar_re, (1, L, S5_GROUPS, S5_STATE))
    a_seq_im = jnp.broadcast_to(abar_im, (1, L, S5_GROUPS, S5_STATE))
    _, _, s_re, s_im = lax.associative_scan(
        _complex_affine_combine, (a_seq_re, a_seq_im, bb_re, bb_im), axis=1)
    y = (jnp.einsum('blgp,gcp->blgc', s_re, c_re.astype(f32))
         - jnp.einsum('blgp,gcp->blgc', s_im, c_im.astype(f32))
         + d.astype(f32) * uf)
    y = y.reshape(bsz, L, S5_WIDTH)
    z = jax.nn.gelu(y)
    z = z * jax.nn.sigmoid(z @ w_glu.astype(f32) + b_glu.astype(f32))
    return z.astype(u.dtype)


def _hgrn2_branch(q_in, f_in, i_in, g_in, lb, norm_g):
    bsz, L, _ = q_in.shape
    f32 = jnp.float32
    n_chunks = L // HGRN_CHUNK

    def heads(t):
        return t.reshape(bsz, n_chunks, HGRN_CHUNK, HGRN_HEADS, HGRN_HEAD_DIM).transpose(1, 0, 3, 2, 4)

    q = jax.nn.silu(q_in.astype(f32))
    zf = f_in.astype(f32)
    lbf = lb.astype(f32)
    log_f = jnp.logaddexp(jnp.log(lbf), jnp.log1p(-lbf) + jax.nn.log_sigmoid(zf))
    k = (1.0 - lbf) * jax.nn.sigmoid(-zf)
    v = i_in.astype(f32)
    causal = jnp.tril(jnp.ones((HGRN_CHUNK, HGRN_CHUNK), dtype=bool))

    def step(S, blk):
        qc, lfc, kc, vc = blk
        b = jnp.cumsum(lfc, axis=2)
        b_last = b[:, :, -1:, :]
        inter = jnp.einsum('bhtk,bhkv->bhtv', qc * jnp.exp(b), S)
        diff = b[:, :, :, None, :] - b[:, :, None, :, :]
        decay = jnp.exp(jnp.where(causal[None, None, :, :, None], diff, -jnp.inf))
        scores = jnp.einsum('bhtk,bhsk,bhtsk->bhts', qc, kc, decay)
        intra = jnp.einsum('bhts,bhsv->bhtv', scores, vc)
        S_new = (jnp.exp(b_last[:, :, 0, :])[..., None] * S
                 + jnp.einsum('bhsk,bhsv->bhkv', kc * jnp.exp(b_last - b), vc))
        return S_new, inter + intra

    S0 = jnp.zeros((bsz, HGRN_HEADS, HGRN_HEAD_DIM, HGRN_HEAD_DIM), f32)
    _, o = lax.scan(step, S0, (heads(q), heads(log_f), heads(k), heads(v)))
    o = o.transpose(1, 0, 3, 2, 4).reshape(bsz, L, HGRN_HEADS, HGRN_HEAD_DIM)
    o = o * lax.rsqrt(jnp.mean(o * o, axis=-1, keepdims=True) + RMS_EPS)
    o = o * norm_g.astype(f32).reshape(HGRN_HEADS, HGRN_HEAD_DIM)
    o = o.reshape(bsz, L, HGRN_WIDTH) * jax.nn.silu(g_in.astype(f32))
    return o.astype(q_in.dtype)


def _conv_glu_ffn(h, w_up, conv_w, conv_b, w_down):
    L = h.shape[1]
    up = h @ w_up
    up_pad = jnp.pad(up, ((0, 0), (CONV_WIDTH - 1, 0), (0, 0)))
    conv = conv_b
    for j in range(CONV_WIDTH):
        conv = conv + conv_w[j] * up_pad[:, j:j + L, :]
    gate, val = jnp.split(conv, 2, axis=-1)
    return (jax.nn.silu(gate) * val) @ w_down


def setup_inputs(seed: int = 0) -> dict:
    key = jax.random.key(seed)
    ks = jax.random.split(key, 24)
    f32 = jnp.float32

    def nrm(k, shape, scale):
        return jax.random.normal(k, shape, f32) * scale

    G, P = S5_GROUPS, S5_STATE
    return {
        'x': nrm(ks[0], (BATCH, SEQ, D_MODEL), 1.0),
        'ln_mix_g': 1.0 + nrm(ks[1], (DEPTH, D_MODEL), 0.01),
        'w_in': nrm(ks[2], (DEPTH, D_MODEL, N_IN), D_MODEL ** -0.5),
        's5_a_re': -0.5 + nrm(ks[3], (DEPTH, G, P), 0.01),
        's5_a_im': math.pi * jnp.arange(P, dtype=f32) + nrm(ks[4], (DEPTH, G, P), 0.01),
        's5_log_dt': jax.random.uniform(ks[5], (DEPTH, G), f32, math.log(DT_MIN), math.log(DT_MAX)),
        's5_b_re': nrm(ks[6], (DEPTH, G, P, S5_GROUP), (2 * S5_GROUP) ** -0.5),
        's5_b_im': nrm(ks[7], (DEPTH, G, P, S5_GROUP), (2 * S5_GROUP) ** -0.5),
        's5_c_re': nrm(ks[8], (DEPTH, G, S5_GROUP, P), S5_STATE ** -0.5),
        's5_c_im': nrm(ks[9], (DEPTH, G, S5_GROUP, P), S5_STATE ** -0.5),
        's5_d': nrm(ks[10], (DEPTH, G, S5_GROUP), 1.0),
        's5_w_glu': nrm(ks[11], (DEPTH, S5_WIDTH, S5_WIDTH), S5_WIDTH ** -0.5),
        's5_b_glu': nrm(ks[12], (DEPTH, S5_WIDTH), 0.01),
        'w_proj_s5': nrm(ks[13], (DEPTH, S5_WIDTH, D_MODEL), S5_WIDTH ** -0.5),
        'hgrn_lb_logits': nrm(ks[14], (DEPTH + 1, HGRN_WIDTH), 0.1),
        'hgrn_norm_g': 1.0 + nrm(ks[15], (DEPTH, HGRN_WIDTH), 0.01),
        'w_proj_hgrn': nrm(ks[16], (DEPTH, HGRN_WIDTH, D_MODEL), HGRN_WIDTH ** -0.5),
        'w_out': nrm(ks[17], (DEPTH, D_MODEL, D_MODEL), D_MODEL ** -0.5),
        'ln_ffn_g': 1.0 + nrm(ks[18], (DEPTH, D_MODEL), 0.01),
        'w_up': nrm(ks[19], (DEPTH, D_MODEL, 2 * D_FF), D_MODEL ** -0.5),
        'conv_w': nrm(ks[20], (DEPTH, CONV_WIDTH, 2 * D_FF), CONV_WIDTH ** -0.5),
        'conv_b': nrm(ks[21], (DEPTH, 2 * D_FF), 0.01),
        'w_down': nrm(ks[22], (DEPTH, D_FF, D_MODEL), D_FF ** -0.5),
        'ln_final_g': 1.0 + nrm(ks[23], (D_MODEL,), 0.01),
    }


def reference(x, ln_mix_g, w_in, s5_a_re, s5_a_im, s5_log_dt, s5_b_re, s5_b_im, s5_c_re, s5_c_im,
              s5_d, s5_w_glu, s5_b_glu, w_proj_s5, hgrn_lb_logits, hgrn_norm_g, w_proj_hgrn,
              w_out, ln_ffn_g, w_up, conv_w, conv_b, w_down, ln_final_g):
    lb_all = jnp.cumsum(jax.nn.softmax(hgrn_lb_logits.astype(jnp.float32), axis=0), axis=0)
    for l in range(DEPTH):
        h = _rmsnorm(x, ln_mix_g[l])
        proj = h @ w_in[l]
        u_s5, q_h, f_h, i_h, g_h, gate_s5, gate_hgrn = jnp.split(proj, _in_splits(), axis=-1)
        y_s5 = _s5_branch(u_s5, s5_a_re[l], s5_a_im[l], s5_log_dt[l], s5_b_re[l], s5_b_im[l],
                          s5_c_re[l], s5_c_im[l], s5_d[l], s5_w_glu[l], s5_b_glu[l]) @ w_proj_s5[l]
        y_hgrn = _hgrn2_branch(q_h, f_h, i_h, g_h, lb_all[l], hgrn_norm_g[l]) @ w_proj_hgrn[l]
        merged = jax.nn.sigmoid(gate_s5) * y_s5 + jax.nn.sigmoid(gate_hgrn) * y_hgrn
        x = x + merged @ w_out[l]
        x = x + _conv_glu_ffn(_rmsnorm(x, ln_ffn_g[l]), w_up[l], conv_w[l], conv_b[l], w_down[l])
    return _rmsnorm(x, ln_final_g)
```

```cpp
#include <hip/hip_runtime.h>
#include <hip/hip_cooperative_groups.h>
namespace cg = cooperative_groups;
#include <cstdio>
#include <cstdint>
namespace pg8 {
#define PG8_LAS __attribute__((address_space(3)))
typedef unsigned short bf16_t;
typedef short bf16x8 __attribute__((ext_vector_type(8)));
typedef float f32x4 __attribute__((ext_vector_type(4)));
typedef unsigned u32x4 __attribute__((ext_vector_type(4)));
constexpr int BM = 256, BK = 64, HALF = 128, HTB = HALF * BK * 2  , STAGE_BYTES = 8 * HTB, NXCD = 8, WGM = 8;

__host__ __device__ __forceinline__ int lds_byte(int r, int c) { const int st = (r >> 4) * 2 + (c >> 5), rr = r & 15, cc = c & 31, ob = rr * 64 + cc * 2; return st * 1024 + (ob ^ (((ob >> 9) & 1) << 5)); }
__host__ __device__ __forceinline__ void stage_rc(int b, int& R, int& C) { const int st = b / 1024, sb = b % 1024, swz = sb ^ (((sb >> 9) & 1) << 5); R = (st >> 1) * 16 + swz / 64; C = (st & 1) * 32 + (swz % 64) / 2; }
__host__ __device__ __forceinline__ int perm32(int rho) { const int n = rho >> 4, i = rho & 15; return 8 * (i >> 2) + 4 * n + (i & 3); }

struct Unit { int pm, pn, seg; };
struct Gemm { const bf16_t* A; const bf16_t* Bt; const bf16_t* A2; const bf16_t* Bt2; int M, N, K, pad; };

struct StaticOrder {
    int nM, nN, nwg, G, c;
    __host__ __device__ void init(int M, int N, int G_, int c_) { nM = M / BM; nN = N / BM; nwg = nM * nN; G = G_; c = c_; }
    __host__ __device__ bool next(int i, Unit& u) const {
        const long L = (long)i * G + c; if (L >= nwg) return false;
        int wgid = (int)L; { const int q = nwg / NXCD, r = nwg % NXCD, xcd = wgid % NXCD, off = wgid / NXCD; wgid = (xcd < r ? xcd * (q + 1) : r * (q + 1) + (xcd - r) * q) + off; }
        const int nig = WGM * nN, gid = wgid / nig, fm = gid * WGM, gsz = (nM - fm) < WGM ? (nM - fm) : WGM;
        u.pm = fm + ((wgid % nig) % gsz); u.pn = (wgid % nig) / gsz; u.seg = 0; return true;
    }
    __device__ __forceinline__ void a_ready(const Unit&) const {}
    __device__ __forceinline__ void done(const Unit&) const {}
};
struct PairOrder : StaticOrder { __host__ __device__ bool next(int i, Unit& u) const { if (!StaticOrder::next(i >> 1, u)) return false; u.seg = i & 1; return true; } };

typedef float f32x2_cv __attribute__((ext_vector_type(2))); typedef __bf16 bf16x2_cv __attribute__((ext_vector_type(2)));
__device__ __forceinline__ unsigned cvt_pk_bf16(float lo, float hi) { f32x2_cv v = {lo, hi}; bf16x2_cv b = __builtin_convertvector(v, bf16x2_cv); return __builtin_bit_cast(unsigned, b); }
template <class Epi, class Sched, bool ALIGN_EPI = false, bool SP2 = false>
__device__ __forceinline__ void gemm_phase(PG8_LAS unsigned char* lds, const Gemm g, const Sched& S, const Epi& E) {
    const int tid = threadIdx.x, wid = __builtin_amdgcn_readfirstlane(tid >> 6), lane = tid & 63, wr = wid >> 2, wc = wid & 3, fr = lane & 15, fq = lane >> 4;
    const int K = g.K, nt = K / BK;
    unsigned voffA[2], voffB[2];
#pragma unroll
    for (int i = 0; i < 2; ++i) { int R, C; stage_rc(tid * 16 + i * 8192, R, C); const int Rb = Epi::PERM ? ((R & ~31) + perm32(R & 31)) : R;
        voffA[i] = (unsigned)(R * K + C) * 2u; voffB[i] = (unsigned)(Rb * K + C) * 2u; }
    const size_t kstep = (size_t)(BK * 2);
    const size_t hstep = (size_t)HALF * K * 2;
    const size_t tstep = 2 * hstep;
    const unsigned ldsw = (unsigned)wid * 1024u;
    const int aoff = lds_byte(wr * 64 + fr, fq * 8), boff = lds_byte(wc * 32 + fr, fq * 8);
#define PG8_SA(b, h) (((b) * 2 + (h)) * HTB)
#define PG8_SB(b, h) ((4 + (b) * 2 + (h)) * HTB)
#define PG8_STAGE(bufoff, gbase, voff) do { _Pragma("unroll") for (int _i = 0; _i < 2; ++_i) \
        __builtin_amdgcn_global_load_lds((const unsigned*)((const char*)(gbase) + (voff)[_i]), (PG8_LAS unsigned*)(lds + (bufoff) + ldsw + _i * 8192), 16, 0, 0); } while (0)
#define PG8_LDA(dst, b, h) do { _Pragma("unroll") for (int m = 0; m < 4; ++m) _Pragma("unroll") for (int k = 0; k < 2; ++k) dst[m][k] = *(const PG8_LAS bf16x8*)(lds + PG8_SA(b, h) + aoff + m * 2048 + k * 1024); } while (0)
#define PG8_LDB(dst, b, h) do { _Pragma("unroll") for (int n = 0; n < 2; ++n) _Pragma("unroll") for (int k = 0; k < 2; ++k) dst[n][k] = *(const PG8_LAS bf16x8*)(lds + PG8_SB(b, h) + boff + n * 2048 + k * 1024); } while (0)
#define PG8_MMA(ai, bj, At, Bt) do { __builtin_amdgcn_s_setprio(1); _Pragma("unroll") for (int m = 0; m < 4; ++m) _Pragma("unroll") for (int n = 0; n < 2; ++n) _Pragma("unroll") for (int k = 0; k < 2; ++k) \
        acc[ai][bj][m][n] = __builtin_amdgcn_mfma_f32_16x16x32_bf16(Bt[n][k], At[m][k], acc[ai][bj][m][n], 0, 0, 0); __builtin_amdgcn_s_setprio(0); } while (0)
#define PG8_WAIT_V(n) asm volatile("s_waitcnt vmcnt(" #n ")" ::: "memory")
#define PG8_WAIT_L(n) asm volatile("s_waitcnt lgkmcnt(" #n ")" ::: "memory")
#define PG8_BAR __builtin_amdgcn_s_barrier()
#define PG8_SCHED __builtin_amdgcn_sched_barrier(0)
    Unit cur, nxt; int ui = 0;
    if (!S.next(0, cur)) return;
    f32x4 acc[2][2][4][2];
#pragma unroll
    for (int a = 0; a < 2; ++a)
#pragma unroll
        for (int b = 0; b < 2; ++b)
#pragma unroll
            for (int m = 0; m < 4; ++m)
#pragma unroll
                for (int n = 0; n < 2; ++n) acc[a][b][m][n] = (f32x4){0.f, 0.f, 0.f, 0.f};
    bf16x8 At[4][2], B0[2][2], B1[2][2];
    const char* cA = (const char*)(cur.seg ? g.A2 : g.A) + (size_t)cur.pm * tstep; const char* cB = (const char*)(cur.seg ? g.Bt2 : g.Bt) + (size_t)cur.pn * tstep;
    S.a_ready(cur);
    if constexpr (SP2) {
        PG8_STAGE(PG8_SB(0, 0), cB, voffB); PG8_STAGE(PG8_SB(0, 1), cB + hstep, voffB); PG8_STAGE(PG8_SA(0, 0), cA, voffA); PG8_STAGE(PG8_SA(0, 1), cA + hstep, voffA);
        if (wr == 1) PG8_BAR;
        PG8_WAIT_V(2); PG8_BAR;
        PG8_STAGE(PG8_SB(1, 0), cB + kstep, voffB); PG8_STAGE(PG8_SA(1, 0), cA + kstep, voffA); PG8_STAGE(PG8_SB(1, 1), cB + hstep + kstep, voffB);
        PG8_WAIT_V(6); PG8_BAR;
    } else {
        PG8_STAGE(PG8_SB(0, 0), cB, voffB); PG8_STAGE(PG8_SA(0, 0), cA, voffA); PG8_STAGE(PG8_SB(0, 1), cB + hstep, voffB); PG8_STAGE(PG8_SA(0, 1), cA + hstep, voffA);
        if (wr == 1) PG8_BAR;
        PG8_WAIT_V(4); PG8_BAR;
        PG8_STAGE(PG8_SB(1, 0), cB + kstep, voffB); PG8_STAGE(PG8_SA(1, 0), cA + kstep, voffA); PG8_STAGE(PG8_SB(1, 1), cB + hstep + kstep, voffB);
        PG8_WAIT_V(6); PG8_BAR;
    }
    for (;;) {
        const bool has_next = S.next(ui + 1, nxt);
        const char* nA = has_next ? (const char*)(nxt.seg ? g.A2 : g.A) + (size_t)nxt.pm * tstep : cA; const char* nB = has_next ? (const char*)(nxt.seg ? g.Bt2 : g.Bt) + (size_t)nxt.pn * tstep : cB;
        for (int t = 0; t < nt; t += 2) {
            const bool last = (t == nt - 2);
            const char* a1 = cA + (size_t)(t + 1) * kstep;
            const char* a2 = last ? nA : cA + (size_t)(t + 2) * kstep; const char* b2 = last ? nB : cB + (size_t)(t + 2) * kstep;
            const char* a3 = a2 + kstep; const char* b3 = b2 + kstep;
            if (last && has_next) S.a_ready(nxt);
            if constexpr (SP2) {
            PG8_LDB(B0, 0, 0); PG8_LDB(B1, 0, 1); PG8_SCHED; PG8_LDA(At, 0, 0); PG8_STAGE(PG8_SA(1, 1), a1 + hstep, voffA);
            PG8_WAIT_V(8); PG8_WAIT_L(0); PG8_BAR; PG8_MMA(0, 0, At, B0); PG8_MMA(0, 1, At, B1); PG8_BAR; PG8_SCHED;
            PG8_LDA(At, 0, 1); PG8_STAGE(PG8_SB(0, 0), b2, voffB); PG8_STAGE(PG8_SB(0, 1), b2 + hstep, voffB); PG8_STAGE(PG8_SA(0, 0), a2, voffA);
            PG8_WAIT_V(8); PG8_WAIT_L(0); PG8_BAR; PG8_MMA(1, 0, At, B0); PG8_MMA(1, 1, At, B1); PG8_BAR; PG8_SCHED;
            PG8_LDB(B0, 1, 0); PG8_LDB(B1, 1, 1); PG8_SCHED; PG8_LDA(At, 1, 0); PG8_STAGE(PG8_SA(0, 1), a2 + hstep, voffA);
            PG8_WAIT_V(8); PG8_WAIT_L(0); PG8_BAR; PG8_MMA(0, 0, At, B0); PG8_MMA(0, 1, At, B1); PG8_BAR; PG8_SCHED;
            PG8_LDA(At, 1, 1); PG8_STAGE(PG8_SB(1, 0), b3, voffB); PG8_STAGE(PG8_SB(1, 1), b3 + hstep, voffB); PG8_STAGE(PG8_SA(1, 0), a3, voffA);
            PG8_WAIT_V(8); PG8_WAIT_L(0); PG8_BAR; PG8_MMA(1, 0, At, B0); PG8_MMA(1, 1, At, B1); PG8_BAR; PG8_SCHED;
            } else {
            PG8_LDB(B0, 0, 0); PG8_SCHED; PG8_LDA(At, 0, 0); PG8_STAGE(PG8_SA(1, 1), a1 + hstep, voffA);
            PG8_WAIT_L(8); PG8_BAR; PG8_WAIT_L(0); PG8_MMA(0, 0, At, B0); PG8_BAR; PG8_SCHED;
            PG8_LDB(B1, 0, 1); PG8_STAGE(PG8_SB(0, 0), b2, voffB);
            PG8_BAR; PG8_WAIT_L(0); PG8_MMA(0, 1, At, B1); PG8_BAR;
            PG8_LDA(At, 0, 1); PG8_STAGE(PG8_SA(0, 0), a2, voffA);
            PG8_BAR; PG8_WAIT_L(0); PG8_MMA(1, 0, At, B0); PG8_BAR; PG8_SCHED;
            PG8_STAGE(PG8_SB(0, 1), b2 + hstep, voffB);
            PG8_WAIT_V(6); PG8_BAR; PG8_MMA(1, 1, At, B1); PG8_BAR;
            PG8_LDB(B0, 1, 0); PG8_SCHED; PG8_LDA(At, 1, 0); PG8_STAGE(PG8_SA(0, 1), a2 + hstep, voffA);
            PG8_WAIT_L(8); PG8_BAR; PG8_WAIT_L(0); PG8_MMA(0, 0, At, B0); PG8_BAR; PG8_SCHED;
            PG8_LDB(B1, 1, 1); PG8_STAGE(PG8_SB(1, 0), b3, voffB);
            PG8_BAR; PG8_WAIT_L(0); PG8_MMA(0, 1, At, B1); PG8_BAR;
            PG8_LDA(At, 1, 1); PG8_STAGE(PG8_SA(1, 0), a3, voffA);
            PG8_BAR; PG8_WAIT_L(0); PG8_MMA(1, 0, At, B0); PG8_BAR; PG8_SCHED;
            PG8_STAGE(PG8_SB(1, 1), b3 + hstep, voffB);
            PG8_WAIT_V(6); PG8_BAR; PG8_MMA(1, 1, At, B1); PG8_BAR;
            }
        }
        if constexpr (ALIGN_EPI) { if (wr == 0) PG8_BAR; }
        if constexpr (!Epi::AFTER_DRAIN) { E(acc, cur, wr, wc, fr, fq); S.done(cur); }
        if (!has_next) break;
#pragma unroll
        for (int a = 0; a < 2; ++a)
#pragma unroll
            for (int b = 0; b < 2; ++b)
#pragma unroll
                for (int m = 0; m < 4; ++m)
#pragma unroll
                    for (int n = 0; n < 2; ++n) acc[a][b][m][n] = (f32x4){0.f, 0.f, 0.f, 0.f};
        cur = nxt; cA = nA; cB = nB; ++ui;
        if constexpr (ALIGN_EPI) { if (wr == 1) PG8_BAR; }
    }
    PG8_WAIT_V(0);
    if constexpr (!ALIGN_EPI) { if (wr == 0) PG8_BAR; }
    PG8_BAR;
    if constexpr (Epi::AFTER_DRAIN) { E.fused(acc, cur, wr, wc, fr, fq, lds, wid, lane); S.done(cur); }
#undef PG8_SA
#undef PG8_SB
#undef PG8_STAGE
#undef PG8_LDA
#undef PG8_LDB
#undef PG8_MMA
#undef PG8_WAIT_V
#undef PG8_WAIT_L
#undef PG8_BAR
#undef PG8_SCHED
}
}

typedef pg8::bf16_t bf16_t;
typedef pg8::f32x4 f32x4;
typedef pg8::u32x4 u32x4;
typedef unsigned u32x2 __attribute__((ext_vector_type(2)));
typedef pg8::Unit Unit;
#define LAS __attribute__((address_space(3)))

constexpr int T_ = 16384, D_ = 2048, L_ = 4096, NIN = 9216, W5 = 1024, HW = 1024, FF = 5632, NUP = 11264;
constexpr float RMS_EPS = 1e-6f;
constexpr size_t MiB = (size_t)1 << 20;
constexpr size_t WS_CTL = 0;
constexpr size_t CTL_SSQ2 = 256 * 1024, CTL_SSQ3 = 384 * 1024;
constexpr size_t WS_S5TAB = 1 * MiB;
constexpr size_t WS_RSTD1 = 12 * MiB, WS_LB = 12 * MiB + 192 * 1024, WS_EGL = 13 * MiB;
constexpr size_t WS_WGLU = 16 * MiB, WS_WPS5 = 18 * MiB, WS_WPH = 22 * MiB, WS_WOUT = 26 * MiB, WS_WDOWN = 34 * MiB, WS_WUP = 56 * MiB, WS_WIN = 100 * MiB;
constexpr size_t WS_XB = 136 * MiB, WS_UG = 200 * MiB, WS_QD = 232 * MiB, WS_KD = 264 * MiB, WS_V = 296 * MiB, WS_G = 328 * MiB;
constexpr size_t WS_LOGF = 360 * MiB, WS_SQ = 424 * MiB, WS_KKR = 456 * MiB;
constexpr size_t WS_Z = 136 * MiB, WS_ZS = 168 * MiB, WS_OH = 200 * MiB, WS_ORAW = 424 * MiB, WS_ORAW_NAIVE = 232 * MiB, WS_SSQH = 488 * MiB;
constexpr size_t WS_MERGED = 232 * MiB, WS_X1B = 296 * MiB, WS_ACT = 100 * MiB, WS_RAW = 360 * MiB, WS_UPQ = 360 * MiB  ;

__device__ __forceinline__ float bf2f(unsigned short b) { return __uint_as_float(((unsigned)b) << 16); }
__device__ __forceinline__ float sigmoid_f(float x) { return __builtin_amdgcn_rcpf(1.0f + __expf(-x)); }
__device__ __forceinline__ float silu_f(float x) { return x * sigmoid_f(x); }
__device__ __forceinline__ float gelu_tanh_f(float x) { const float a = 1.5957691216057308f * (x + 0.044715f * x * x * x); return x * sigmoid_f(a); }
__device__ __forceinline__ u32x4 pack8(const float* v) { u32x4 w; w.x = pg8::cvt_pk_bf16(v[0], v[1]); w.y = pg8::cvt_pk_bf16(v[2], v[3]); w.z = pg8::cvt_pk_bf16(v[4], v[5]); w.w = pg8::cvt_pk_bf16(v[6], v[7]); return w; }
__device__ __forceinline__ void unpack8(const u32x4 w, float* v) { v[0] = __uint_as_float(w.x << 16); v[1] = __uint_as_float(w.x & 0xffff0000u); v[2] = __uint_as_float(w.y << 16); v[3] = __uint_as_float(w.y & 0xffff0000u);
    v[4] = __uint_as_float(w.z << 16); v[5] = __uint_as_float(w.z & 0xffff0000u); v[6] = __uint_as_float(w.w << 16); v[7] = __uint_as_float(w.w & 0xffff0000u); }
#define ACC8(v, a, sc) do { v[0] = a[0][0] * (sc); v[1] = a[0][1] * (sc); v[2] = a[0][2] * (sc); v[3] = a[0][3] * (sc); v[4] = a[1][0] * (sc); v[5] = a[1][1] * (sc); v[6] = a[1][2] * (sc); v[7] = a[1][3] * (sc); } while (0)

struct EpiProj {
    static constexpr bool PERM = true, AFTER_DRAIN = false, MID = false;
    const float* rstd; const float* lb; bf16_t *UG, *SQ, *KKR, *V, *G, *GS5, *GH; float* LOGF;
    __device__ __forceinline__ void operator()(const f32x4 (&acc)[2][2][4][2], const Unit& u, int wr, int wc, int fr, int fq) const {
        const int rowb = u.pm * 256 + wr * 64 + fr, cb = wc * 32 + 8 * fq, pn = u.pn;
#pragma unroll
        for (int ai = 0; ai < 2; ++ai)
#pragma unroll
            for (int m = 0; m < 4; ++m) {
                const int row = rowb + ai * 128 + m * 16; const float s = rstd[row];
#pragma unroll
                for (int bj = 0; bj < 2; ++bj) {
                    float v[8]; ACC8(v, acc[ai][bj][m], s);
                    if (pn < 4) { const int col = pn * 256 + bj * 128 + cb, g = col >> 4, c = col & 15, b = row >> 12, t = row & 4095;
                        *(u32x4*)(UG + (((size_t)(b * 64 + g) * L_ + t) * 16 + c)) = pack8(v); }
                    else if (pn < 12) { const int ch = (pn - 4) * 128 + cb;
                        if (bj == 0) { float o[8];
#pragma unroll
                            for (int j = 0; j < 8; ++j) o[j] = silu_f(v[j]);
                            *(u32x4*)(SQ + (size_t)row * HW + ch) = pack8(o); }
                        else { float lf[8], kk[8]; const f32x4 l0 = *(const f32x4*)(lb + ch), l1 = *(const f32x4*)(lb + ch + 4);
#pragma unroll
                            for (int j = 0; j < 8; ++j) { const float lbv = j < 4 ? l0[j] : l1[j - 4]; const float sg = sigmoid_f(v[j]); lf[j] = __logf(lbv + (1.0f - lbv) * sg); kk[j] = (1.0f - lbv) * sigmoid_f(-v[j]); }
                            *(f32x4*)(LOGF + (size_t)row * HW + ch) = (f32x4){lf[0], lf[1], lf[2], lf[3]}; *(f32x4*)(LOGF + (size_t)row * HW + ch + 4) = (f32x4){lf[4], lf[5], lf[6], lf[7]};
                            *(u32x4*)(KKR + (size_t)row * HW + ch) = pack8(kk); } }
                    else if (pn < 16) { const int col = (pn - 12) * 256 + bj * 128 + cb; *(u32x4*)(V + (size_t)row * HW + col) = pack8(v); }
                    else if (pn < 20) { const int col = (pn - 16) * 256 + bj * 128 + cb; float o[8];
#pragma unroll
                        for (int j = 0; j < 8; ++j) o[j] = silu_f(v[j]);
                        *(u32x4*)(G + (size_t)row * HW + col) = pack8(o); }
                    else { const int col = ((pn - 20) & 7) * 256 + bj * 128 + cb; float o[8];
#pragma unroll
                        for (int j = 0; j < 8; ++j) o[j] = sigmoid_f(v[j]);
                        *(u32x4*)((pn < 28 ? GS5 : GH) + (size_t)row * D_ + col) = pack8(o); }
                }
            }
    }
};
struct EpiGlu {
    static constexpr bool PERM = true, AFTER_DRAIN = false, MID = false;
    const bf16_t* Z; const float* bias; bf16_t* ZS;
    __device__ __forceinline__ void operator()(const f32x4 (&acc)[2][2][4][2], const Unit& u, int wr, int wc, int fr, int fq) const {
        const int rowb = u.pm * 256 + wr * 64 + fr, colb = u.pn * 256 + wc * 32 + 8 * fq;
#pragma unroll
        for (int ai = 0; ai < 2; ++ai)
#pragma unroll
            for (int m = 0; m < 4; ++m) { const int row = rowb + ai * 128 + m * 16;
#pragma unroll
                for (int bj = 0; bj < 2; ++bj) { const int col = colb + bj * 128; float v[8], z[8], o[8]; ACC8(v, acc[ai][bj][m], 1.0f);
                    unpack8(*(const u32x4*)(Z + (size_t)row * W5 + col), z); const f32x4 b0 = *(const f32x4*)(bias + col), b1 = *(const f32x4*)(bias + col + 4);
#pragma unroll
                    for (int j = 0; j < 8; ++j) o[j] = z[j] * sigmoid_f(v[j] + (j < 4 ? b0[j] : b1[j - 4]));
                    *(u32x4*)(ZS + (size_t)row * W5 + col) = pack8(o); } }
    }
};
struct EpiMerged {
    static constexpr bool PERM = true, AFTER_DRAIN = false, MID = false;
    const bf16_t* GS5; const bf16_t* GH; bf16_t* MERGED;
    __device__ __forceinline__ void operator()(const f32x4 (&acc)[2][2][4][2], const Unit& u, int wr, int wc, int fr, int fq) const {
        const int rowb = u.pm * 256 + wr * 64 + fr, colb = u.pn * 256 + wc * 32 + 8 * fq; const bf16_t* gate = u.seg ? GH : GS5;
#pragma unroll
        for (int ai = 0; ai < 2; ++ai)
#pragma unroll
            for (int m = 0; m < 4; ++m) { const int row = rowb + ai * 128 + m * 16;
#pragma unroll
                for (int bj = 0; bj < 2; ++bj) { const size_t o = (size_t)row * D_ + colb + bj * 128; float v[8], b[8]; ACC8(v, acc[ai][bj][m], 1.0f); unpack8(*(const u32x4*)(gate + o), b);
#pragma unroll
                    for (int j = 0; j < 8; ++j) v[j] *= b[j];
                    if (u.seg) { float p[8]; unpack8(*(const u32x4*)(MERGED + o), p);
#pragma unroll
                        for (int j = 0; j < 8; ++j) v[j] += p[j]; }
                    *(u32x4*)(MERGED + o) = pack8(v); }
                asm volatile("" ::: "memory"); }
    }
};
struct EpiRes {
    static constexpr bool PERM = true, AFTER_DRAIN = false, MID = false;
    const float* XI; float* XO; bf16_t* XBF; float* ssq;
    __device__ __forceinline__ void operator()(const f32x4 (&acc)[2][2][4][2], const Unit& u, int wr, int wc, int fr, int fq) const {
        const int rowb = u.pm * 256 + wr * 64 + fr, colb = u.pn * 256 + wc * 32 + 8 * fq;
#pragma unroll
        for (int ai = 0; ai < 2; ++ai)
#pragma unroll
            for (int m = 0; m < 4; ++m) { const int row = rowb + ai * 128 + m * 16; float sq = 0.f;
#pragma unroll
                for (int bj = 0; bj < 2; ++bj) { const size_t o = (size_t)row * D_ + colb + bj * 128; const f32x4 x0 = *(const f32x4*)(XI + o), x1 = *(const f32x4*)(XI + o + 4);
                    const f32x4 y0 = x0 + acc[ai][bj][m][0], y1 = x1 + acc[ai][bj][m][1];
                    *(f32x4*)(XO + o) = y0; *(f32x4*)(XO + o + 4) = y1;
                    sq += (y0[0] * y0[0] + y0[1] * y0[1]) + (y0[2] * y0[2] + y0[3] * y0[3]) + (y1[0] * y1[0] + y1[1] * y1[1]) + (y1[2] * y1[2] + y1[3] * y1[3]);
                    if (XBF) { float v[8] = {y0[0], y0[1], y0[2], y0[3], y1[0], y1[1], y1[2], y1[3]}; *(u32x4*)(XBF + o) = pack8(v); } }
                sq += __shfl_xor(sq, 16); sq += __shfl_xor(sq, 32);
                if (fq == 0) atomicAdd(ssq + row, sq); }
    }
};
struct EpiUpNaive {
    static constexpr bool PERM = true, AFTER_DRAIN = false, MID = false;
    const float* ssq; bf16_t* UP; int row0, pad;
    __device__ __forceinline__ void operator()(const f32x4 (&acc)[2][2][4][2], const Unit& u, int wr, int wc, int fr, int fq) const {
        const int rowb = u.pm * 256 + wr * 64 + fr, colb = u.pn * 256 + wc * 32 + 8 * fq;
#pragma unroll
        for (int ai = 0; ai < 2; ++ai)
#pragma unroll
            for (int m = 0; m < 4; ++m) { const int row = rowb + ai * 128 + m * 16; const float s = rsqrtf(ssq[row0 + row] * (1.0f / D_) + RMS_EPS);
#pragma unroll
                for (int bj = 0; bj < 2; ++bj) { float v[8]; ACC8(v, acc[ai][bj][m], s); *(u32x4*)(UP + (size_t)row * NUP + colb + bj * 128) = pack8(v); } }
    }
};


__device__ __forceinline__ float dpp_shr0(float x, int) { return x; }
#define DPP_SHR_Z(x, n) __builtin_bit_cast(float, __builtin_amdgcn_update_dpp(0, __builtin_bit_cast(int, (x)), 0x110 + (n), 0xf, 0xf, true))
#define DPP_SHR_OLD(old, x, n) __builtin_bit_cast(float, __builtin_amdgcn_update_dpp(__builtin_bit_cast(int, (old)), __builtin_bit_cast(int, (x)), 0x110 + (n), 0xf, 0xf, false))
#define DPP_ROR(x, n) __builtin_bit_cast(float, __builtin_amdgcn_update_dpp(0, __builtin_bit_cast(int, (x)), 0x120 + (n), 0xf, 0xf, false))

struct EpiProjF {
    static constexpr bool PERM = true, AFTER_DRAIN = false, MID = false;
    const float* rstd; const float* lb; bf16_t *UG, *QD, *KD, *V, *G, *GS5, *GH; float* EGL;
    __device__ __forceinline__ void operator()(const f32x4 (&acc)[2][2][4][2], const Unit& u, int wr, int wc, int fr, int fq) const {
        const int rowb = u.pm * 256 + wr * 64 + fr, cb = wc * 32 + 8 * fq, pn = u.pn;
        if (pn >= 4 && pn < 12) {
            const int ch = (pn - 4) * 128 + cb; const int lane = fq * 16 + fr;
#pragma unroll
            for (int ai = 0; ai < 2; ++ai)
#pragma unroll
                for (int n = 0; n < 2; ++n) {
                    const f32x4 l0 = *(const f32x4*)(lb + ch + 4 * n);
                    float bsum[4][4], kk[4][4];
#pragma unroll
                    for (int m = 0; m < 4; ++m) { const float s = rstd[rowb + ai * 128 + m * 16]; const f32x4 z = acc[ai][1][m][n] * s;
#pragma unroll
                        for (int j = 0; j < 4; ++j) { const float lbv = l0[j]; const float sg = sigmoid_f(z[j]); float x = __logf(lbv + (1.0f - lbv) * sg); kk[m][j] = (1.0f - lbv) * sigmoid_f(-z[j]);
                            x += DPP_SHR_Z(x, 1); x += DPP_SHR_Z(x, 2); x += DPP_SHR_Z(x, 4); x += DPP_SHR_Z(x, 8); bsum[m][j] = x; } }
#pragma unroll
                    for (int j = 0; j < 4; ++j) { float carry = 0.f;
#pragma unroll
                        for (int m = 0; m < 4; ++m) { const float tot = __shfl(bsum[m][j], (lane & 48) | 15); bsum[m][j] += carry; carry += tot; } }
#pragma unroll
                    for (int m = 0; m < 4; ++m) { const int row = rowb + ai * 128 + m * 16; const float s = rstd[row]; const f32x4 q = acc[ai][0][m][n] * s; float oq[4], ok[4];
#pragma unroll
                        for (int j = 0; j < 4; ++j) { oq[j] = silu_f(q[j]) * __expf(bsum[m][j]); ok[j] = kk[m][j] * __expf(-bsum[m][j]); }
                        u32x2 wq, wk; wq.x = pg8::cvt_pk_bf16(oq[0], oq[1]); wq.y = pg8::cvt_pk_bf16(oq[2], oq[3]); wk.x = pg8::cvt_pk_bf16(ok[0], ok[1]); wk.y = pg8::cvt_pk_bf16(ok[2], ok[3]);
                        *(u32x2*)(QD + (size_t)row * HW + ch + 4 * n) = wq; *(u32x2*)(KD + (size_t)row * HW + ch + 4 * n) = wk; }
                    if (fr == 15) { const int chunk = (u.pm * 256 + ai * 128 + wr * 64) >> 6;
                        *(f32x4*)(EGL + (size_t)chunk * HW + ch + 4 * n) = (f32x4){__expf(bsum[3][0]), __expf(bsum[3][1]), __expf(bsum[3][2]), __expf(bsum[3][3])}; }
                    asm volatile("" ::: "memory");
                }
            return;
        }
#pragma unroll
        for (int ai = 0; ai < 2; ++ai)
#pragma unroll
            for (int m = 0; m < 4; ++m) {
                const int row = rowb + ai * 128 + m * 16; const float s = rstd[row];
#pragma unroll
                for (int bj = 0; bj < 2; ++bj) {
                    float v[8]; ACC8(v, acc[ai][bj][m], s);
                    if (pn < 4) { const int col = pn * 256 + bj * 128 + cb, g = col >> 4, c = col & 15, b = row >> 12, t = row & 4095;
                        *(u32x4*)(UG + (((size_t)(b * 64 + g) * L_ + t) * 16 + c)) = pack8(v); }
                    else if (pn < 16) { const int col = (pn - 12) * 256 + bj * 128 + cb; *(u32x4*)(V + (size_t)row * HW + col) = pack8(v); }
                    else if (pn < 20) { const int col = (pn - 16) * 256 + bj * 128 + cb; float o[8];
#pragma unroll
                        for (int j = 0; j < 8; ++j) o[j] = silu_f(v[j]);
                        *(u32x4*)(G + (size_t)row * HW + col) = pack8(o); }
                    else { const int col = ((pn - 20) & 7) * 256 + bj * 128 + cb; float o[8];
#pragma unroll
                        for (int j = 0; j < 8; ++j) o[j] = sigmoid_f(v[j]);
                        *(u32x4*)((pn < 28 ? GS5 : GH) + (size_t)row * D_ + col) = pack8(o); }
                }
            }
    }
};

struct EpiUpConv {
    static constexpr bool PERM = true, AFTER_DRAIN = false, MID = false;
    const float* ssq; const float* cw; const float* cb; bf16_t* ACT; float* RAW;
    __device__ __forceinline__ void operator()(const f32x4 (&acc)[2][2][4][2], const Unit& u, int wr, int wc, int fr, int fq) const {
        const int rowb = u.pm * 256 + wr * 64 + fr, j0 = u.pn * 128 + wc * 32 + 8 * fq;
        float rs[2][4];
#pragma unroll
        for (int ai = 0; ai < 2; ++ai)
#pragma unroll
            for (int m = 0; m < 4; ++m) rs[ai][m] = rsqrtf(ssq[rowb + ai * 128 + m * 16] * (1.0f / D_) + RMS_EPS);
#pragma unroll
        for (int n = 0; n < 2; ++n) { const int j = j0 + 4 * n;
            const f32x4 g0 = *(const f32x4*)(cw + j), g1 = *(const f32x4*)(cw + NUP + j), g2 = *(const f32x4*)(cw + 2 * NUP + j), gb = *(const f32x4*)(cb + j);
            const f32x4 v0 = *(const f32x4*)(cw + FF + j), v1 = *(const f32x4*)(cw + NUP + FF + j), v2 = *(const f32x4*)(cw + 2 * NUP + FF + j), vb = *(const f32x4*)(cb + FF + j);
#pragma unroll
            for (int ai = 0; ai < 2; ++ai) { const int blk = (u.pm * 256 + ai * 128 + wr * 64) >> 6; f32x4 pg = (f32x4){0.f, 0.f, 0.f, 0.f}, pv = pg;
#pragma unroll
                for (int m = 0; m < 4; ++m) { const int row = rowb + ai * 128 + m * 16; const f32x4 ug = acc[ai][0][m][n] * rs[ai][m], uv = acc[ai][1][m][n] * rs[ai][m]; f32x4 cg, cv;
#pragma unroll
                    for (int e = 0; e < 4; ++e) { float ugs = ug[e], uvs = uv[e], pgs = pg[e], pvs = pv[e]; asm volatile("" : "+v"(ugs), "+v"(uvs), "+v"(pgs), "+v"(pvs));
                        float g1s = DPP_SHR_OLD(DPP_ROR(pgs, 1), ugs, 1), g2s = DPP_SHR_OLD(DPP_ROR(pgs, 2), ugs, 2), v1s = DPP_SHR_OLD(DPP_ROR(pvs, 1), uvs, 1), v2s = DPP_SHR_OLD(DPP_ROR(pvs, 2), uvs, 2); asm volatile("" : "+v"(g1s), "+v"(g2s), "+v"(v1s), "+v"(v2s));
                        cg[e] = gb[e] + g0[e] * g2s + g1[e] * g1s + g2[e] * ug[e]; cv[e] = vb[e] + v0[e] * v2s + v1[e] * v1s + v2[e] * uv[e]; }
                    if (m > 0 || fr >= 2) { u32x2 o; o.x = pg8::cvt_pk_bf16(silu_f(cg[0]) * cv[0], silu_f(cg[1]) * cv[1]); o.y = pg8::cvt_pk_bf16(silu_f(cg[2]) * cv[2], silu_f(cg[3]) * cv[3]); *(u32x2*)(ACT + (size_t)row * FF + j) = o; }
                    if (m == 0 && fr < 2) { float* r = RAW + ((size_t)blk * 4 + 2 + fr) * NUP; *(f32x4*)(r + j) = ug; *(f32x4*)(r + FF + j) = uv; }
                    if (m == 3 && fr >= 14) { float* r = RAW + ((size_t)blk * 4 + (fr - 14)) * NUP; *(f32x4*)(r + j) = ug; *(f32x4*)(r + FF + j) = uv; }
                    pg = ug; pv = uv; } } }
    }
};
__device__ __forceinline__ void conv_fixup(const float* RAW, const float* cw, const float* cb, bf16_t* ACT, int blk0, int nblk, int tid0, int nthreads) {
    for (int it = tid0; it < nblk * (FF / 4); it += nthreads) { const int blk = blk0 + it / (FF / 4), j = (it % (FF / 4)) * 4; const bool first = (blk & 63) == 0;
        const float* rp = RAW + (size_t)(blk - 1) * 4 * NUP; const float* rc = RAW + (size_t)blk * 4 * NUP; const f32x4 z4 = (f32x4){0.f, 0.f, 0.f, 0.f};
        f32x4 g[4], v[4];
        g[0] = first ? z4 : *(const f32x4*)(rp + j); g[1] = first ? z4 : *(const f32x4*)(rp + NUP + j); g[2] = *(const f32x4*)(rc + 2 * NUP + j); g[3] = *(const f32x4*)(rc + 3 * NUP + j);
        v[0] = first ? z4 : *(const f32x4*)(rp + FF + j); v[1] = first ? z4 : *(const f32x4*)(rp + NUP + FF + j); v[2] = *(const f32x4*)(rc + 2 * NUP + FF + j); v[3] = *(const f32x4*)(rc + 3 * NUP + FF + j);
        const f32x4 g0 = *(const f32x4*)(cw + j), g1 = *(const f32x4*)(cw + NUP + j), g2 = *(const f32x4*)(cw + 2 * NUP + j), gb = *(const f32x4*)(cb + j);
        const f32x4 v0 = *(const f32x4*)(cw + FF + j), v1 = *(const f32x4*)(cw + NUP + FF + j), v2 = *(const f32x4*)(cw + 2 * NUP + FF + j), vb = *(const f32x4*)(cb + FF + j);
#pragma unroll
        for (int pos = 0; pos < 2; ++pos) { const f32x4 cg = gb + g0 * g[pos] + g1 * g[pos + 1] + g2 * g[pos + 2], cv = vb + v0 * v[pos] + v1 * v[pos + 1] + v2 * v[pos + 2];
            u32x2 o; o.x = pg8::cvt_pk_bf16(silu_f(cg[0]) * cv[0], silu_f(cg[1]) * cv[1]); o.y = pg8::cvt_pk_bf16(silu_f(cg[2]) * cv[2], silu_f(cg[3]) * cv[3]); *(u32x2*)(ACT + ((size_t)blk * 64 + pos) * FF + j) = o; } }
}
__global__ void __launch_bounds__(512, 2) k_conv_fixup(const float* RAW, const float* cw, const float* cb, bf16_t* ACT) { conv_fixup(RAW, cw, cb, ACT, 0, 256, blockIdx.x * 512 + threadIdx.x, gridDim.x * 512); }

__global__ void __launch_bounds__(512, 2) k_gemm_pair(pg8::Gemm g, EpiMerged E) {
    extern __shared__ __attribute__((aligned(16))) unsigned char lds[];
    pg8::PairOrder S; S.init(g.M, g.N, (int)gridDim.x, (int)blockIdx.x);
    pg8::gemm_phase<EpiMerged, pg8::PairOrder, true, true>((LAS unsigned char*)lds, g, S, E);
}
template <class Epi> __global__ void __launch_bounds__(512, 2) k_gemm(pg8::Gemm g, Epi E) {
    extern __shared__ __attribute__((aligned(16))) unsigned char lds[];
    pg8::StaticOrder S; S.init(g.M, g.N, (int)gridDim.x, (int)blockIdx.x);
    pg8::gemm_phase<Epi, pg8::StaticOrder, true, true>((LAS unsigned char*)lds, g, S, E);
}

__device__ __forceinline__ int dest_row(int mode, int n) {
    if (mode == 1) { if (n >= 1024 && n < 2048) { const int i = n - 1024; return 1024 + 256 * (i >> 7) + (i & 127); } if (n >= 2048 && n < 3072) { const int i = n - 2048; return 1024 + 256 * (i >> 7) + 128 + (i & 127); } return n; }
    if (mode == 2) { if (n < FF) return 256 * (n >> 7) + (n & 127); const int i = n - FF; return 256 * (i >> 7) + 128 + (i & 127); }
    return n;
}
__device__ __forceinline__ void transpose_item(const float* W, const float* gain, int K, int N, bf16_t* WT, int mode, LAS float* scr, int item, int lane) {
    const int nblk = N / 32, kb = item / nblk, nb = item % nblk, k0 = 64 * kb, n0 = 32 * nb;
#pragma unroll 8
    for (int i = 0; i < 32; ++i) { const int kk = 2 * i + (lane >> 5); float w = W[(size_t)(k0 + kk) * N + n0 + (lane & 31)]; if (gain) w *= gain[k0 + kk]; scr[kk * 33 + (lane & 31)] = w; }
    asm volatile("s_waitcnt lgkmcnt(0)" ::: "memory");
    const int c = lane & 7; const int r0 = dest_row(mode, n0);
#pragma unroll
    for (int j = 0; j < 4; ++j) { const int n = (lane >> 3) + 8 * j; const LAS float* s = scr + (8 * c) * 33 + n;
        u32x4 o; o.x = pg8::cvt_pk_bf16(s[0 * 33], s[1 * 33]); o.y = pg8::cvt_pk_bf16(s[2 * 33], s[3 * 33]); o.z = pg8::cvt_pk_bf16(s[4 * 33], s[5 * 33]); o.w = pg8::cvt_pk_bf16(s[6 * 33], s[7 * 33]);
        *(u32x4*)(WT + (size_t)(r0 + n) * K + k0 + 8 * c) = o; }
    asm volatile("s_waitcnt lgkmcnt(0)" ::: "memory");
}
struct PrepArgs { const float *x, *ln_mix_g, *w_in, *w_glu, *w_ps5, *w_ph, *w_out, *ln_ffn_g, *w_up, *w_down, *lb_logits; unsigned char* ws; };
__device__ __forceinline__ void prep_phase(const PrepArgs& a, LAS unsigned char* lds, int gw, int ngw, int lane) {
    LAS float* scr = (LAS float*)(lds + (threadIdx.x >> 6) * 16384);
    unsigned char* ws = a.ws;
    constexpr int I_IN = (D_ / 64) * (NIN / 32), I_GLU = (W5 / 64) * (W5 / 32), I_PS = (W5 / 64) * (D_ / 32), I_OUT = (D_ / 64) * (D_ / 32), I_UP = (D_ / 64) * (NUP / 32), I_DN = (FF / 64) * (D_ / 32);
    constexpr int NITEMS = I_IN + I_GLU + 2 * I_PS + I_OUT + I_UP + I_DN;
    for (int it = gw; it < NITEMS; it += ngw) {
        int r = it;
        if (r < I_UP) { transpose_item(a.w_up, a.ln_ffn_g, D_, NUP, (bf16_t*)(ws + WS_WUP), 2, scr, r, lane); continue; } r -= I_UP;
        if (r < I_IN) { transpose_item(a.w_in, a.ln_mix_g, D_, NIN, (bf16_t*)(ws + WS_WIN), 1, scr, r, lane); continue; } r -= I_IN;
        if (r < I_DN) { transpose_item(a.w_down, nullptr, FF, D_, (bf16_t*)(ws + WS_WDOWN), 0, scr, r, lane); continue; } r -= I_DN;
        if (r < I_OUT) { transpose_item(a.w_out, nullptr, D_, D_, (bf16_t*)(ws + WS_WOUT), 0, scr, r, lane); continue; } r -= I_OUT;
        if (r < I_PS) { transpose_item(a.w_ps5, nullptr, W5, D_, (bf16_t*)(ws + WS_WPS5), 0, scr, r, lane); continue; } r -= I_PS;
        if (r < I_PS) { transpose_item(a.w_ph, nullptr, HW, D_, (bf16_t*)(ws + WS_WPH), 0, scr, r, lane); continue; } r -= I_PS;
        transpose_item(a.w_glu, nullptr, W5, W5, (bf16_t*)(ws + WS_WGLU), 0, scr, r, lane);
    }
    bf16_t* XB = (bf16_t*)(ws + WS_XB); float* rstd1 = (float*)(ws + WS_RSTD1);
    for (int row = gw; row < T_; row += ngw) {
        const f32x4* xr = (const f32x4*)(a.x + (size_t)row * D_) + lane; float s = 0.f;
#pragma unroll
        for (int j = 0; j < 8; ++j) { const f32x4 v = xr[64 * j]; s += (v[0] * v[0] + v[1] * v[1]) + (v[2] * v[2] + v[3] * v[3]);
            uint2 o; o.x = pg8::cvt_pk_bf16(v[0], v[1]); o.y = pg8::cvt_pk_bf16(v[2], v[3]); *((uint2*)(XB + (size_t)row * D_) + lane + 64 * j) = o; }
#pragma unroll
        for (int o = 1; o < 64; o <<= 1) s += __shfl_xor(s, o);
        if (lane == 0) rstd1[row] = rsqrtf(s * (1.0f / D_) + RMS_EPS);
    }
    float* LB = (float*)(ws + WS_LB);
    for (int c = gw * 64 + lane; c < HW; c += ngw * 64) { const float l0 = a.lb_logits[c], l1 = a.lb_logits[HW + c]; LB[c] = 1.0f / (1.0f + __expf(l1 - l0)); }
}
__global__ void __launch_bounds__(512, 2) k_prep(PrepArgs a) {
    extern __shared__ __attribute__((aligned(16))) unsigned char lds[];
    prep_phase(a, (LAS unsigned char*)lds, (int)blockIdx.x * 8 + (int)(threadIdx.x >> 6), (int)gridDim.x * 8, (int)(threadIdx.x & 63));
}

__global__ void k_cumsum(const bf16_t* SQ, const float* LOGF, const bf16_t* KKR, bf16_t* QD, bf16_t* KD, float* EGL) {
    const int col = blockIdx.x * blockDim.x + threadIdx.x, chunk = blockIdx.y; float b = 0.f;
    for (int s = 0; s < 64; ++s) { const size_t o = (size_t)(chunk * 64 + s) * HW + col; b += LOGF[o];
        QD[o] = (bf16_t)(pg8::cvt_pk_bf16(bf2f(SQ[o]) * __expf(b), 0.f) & 0xffff); KD[o] = (bf16_t)(pg8::cvt_pk_bf16(bf2f(KKR[o]) * __expf(-b), 0.f) & 0xffff); }
    EGL[(size_t)chunk * HW + col] = __expf(b);
}
struct S5Args { const bf16_t* UG; const float *a_re, *a_im, *log_dt, *b_re, *b_im, *c_re, *c_im, *d; bf16_t* Z; };
__device__ __forceinline__ void sincos_rev(float x, float& s, float& c) { float r = x * 0.15915494309189535f; r -= rintf(r); s = __builtin_amdgcn_sinf(r); c = __builtin_amdgcn_cosf(r); }
__global__ void __launch_bounds__(64) k_s5_naive(S5Args a) {
    const int b = blockIdx.x >> 6, g = blockIdx.x & 63, p = threadIdx.x;
    __shared__ float H[16][128]; __shared__ float CC[16][128]; __shared__ float Us[16][16];
    const float lr = fminf(a.a_re[g * 64 + p], -1e-4f), li = a.a_im[g * 64 + p], dt = __expf(a.log_dt[g]);
    float sn, cs; sincos_rev(li * dt, sn, cs); const float mag = __expf(lr * dt), abr = mag * cs, abi = mag * sn;
    const float den = lr * lr + li * li, nr = abr - 1.0f, ni = abi, cr = (nr * lr + ni * li) / den, ci = (ni * lr - nr * li) / den;
    float Bcr[16], Bci[16];
#pragma unroll
    for (int c = 0; c < 16; ++c) { const float br = a.b_re[(g * 64 + p) * 16 + c], bi = a.b_im[(g * 64 + p) * 16 + c]; Bcr[c] = cr * br - ci * bi; Bci[c] = cr * bi + ci * br;
        CC[c][p] = a.c_re[(g * 16 + c) * 64 + p]; CC[c][64 + p] = -a.c_im[(g * 16 + c) * 64 + p]; }
    float hr = 0.f, hi = 0.f;
    const bf16_t* U = a.UG + (size_t)(b * 64 + g) * L_ * 16;
    for (int t0 = 0; t0 < L_; t0 += 16) {
        __syncthreads();
#pragma unroll
        for (int q = 0; q < 4; ++q) { const int idx = p * 4 + q; Us[idx >> 4][idx & 15] = bf2f(U[(size_t)t0 * 16 + idx]); }
        __syncthreads();
#pragma unroll
        for (int s = 0; s < 16; ++s) { float br = 0.f, bi = 0.f;
#pragma unroll
            for (int c = 0; c < 16; ++c) { br += Bcr[c] * Us[s][c]; bi += Bci[c] * Us[s][c]; }
            const float nhr = abr * hr - abi * hi + br, nhi = abr * hi + abi * hr + bi; hr = nhr; hi = nhi; H[s][p] = hr; H[s][64 + p] = hi; }
        __syncthreads();
#pragma unroll
        for (int q = 0; q < 4; ++q) { const int idx = p * 4 + q, s = idx >> 4, c = idx & 15; float y = a.d[g * 16 + c] * Us[s][c];
            for (int k = 0; k < 128; ++k) y += H[s][k] * CC[c][k];
            a.Z[(size_t)(b * L_ + t0 + s) * W5 + g * 16 + c] = (bf16_t)(pg8::cvt_pk_bf16(gelu_tanh_f(y), 0.f) & 0xffff); }
    }
}
__global__ void __launch_bounds__(128) k_hgrn_naive(const bf16_t* SQ, const float* LOGF, const bf16_t* KKR, const bf16_t* V, float* ORAW) {
    const int b = blockIdx.x >> 3, h = blockIdx.x & 7, d = threadIdx.x;
    __shared__ float fs[128], ks[128], qs[128];
    float S[128];
#pragma unroll
    for (int k = 0; k < 128; ++k) S[k] = 0.f;
    for (int t = 0; t < L_; ++t) { const size_t o = (size_t)(b * L_ + t) * HW + h * 128 + d;
        __syncthreads();
        fs[d] = __expf(LOGF[o]); ks[d] = bf2f(KKR[o]); qs[d] = bf2f(SQ[o]);
        const float v = bf2f(V[o]);
        __syncthreads();
        float acc = 0.f;
#pragma unroll
        for (int k = 0; k < 128; ++k) { S[k] = fs[k] * S[k] + ks[k] * v; acc += qs[k] * S[k]; }
        ORAW[o] = acc; }
}
__global__ void __launch_bounds__(64) k_oh_naive(const float* ORAW, const bf16_t* G, const float* norm_g, bf16_t* OH) {
    const int row = blockIdx.x >> 3, h = blockIdx.x & 7, lane = threadIdx.x; const size_t o = (size_t)row * HW + h * 128;
    const float o0 = ORAW[o + lane], o1 = ORAW[o + 64 + lane]; float s = o0 * o0 + o1 * o1;
#pragma unroll
    for (int k = 1; k < 64; k <<= 1) s += __shfl_xor(s, k);
    const float r = rsqrtf(s * (1.0f / 128.0f) + RMS_EPS);
    OH[o + lane] = (bf16_t)(pg8::cvt_pk_bf16(o0 * r * norm_g[h * 128 + lane] * bf2f(G[o + lane]), 0.f) & 0xffff);
    OH[o + 64 + lane] = (bf16_t)(pg8::cvt_pk_bf16(o1 * r * norm_g[h * 128 + 64 + lane] * bf2f(G[o + 64 + lane]), 0.f) & 0xffff);
}
__global__ void k_conv_naive(const bf16_t* UPQ, const float* cw, const float* cb, bf16_t* ACT, int row0) {
    const int j = blockIdx.x * blockDim.x + threadIdx.x, t = blockIdx.y; if (j >= FF) return;
    const int cg = 256 * (j >> 7) + (j & 127), cv = cg + 128; float g = cb[j], v = cb[FF + j];
#pragma unroll
    for (int k = 0; k < 3; ++k) { const int tt = t - 2 + k; if (tt >= 0) { g += cw[k * NUP + j] * bf2f(UPQ[(size_t)tt * NUP + cg]); v += cw[k * NUP + FF + j] * bf2f(UPQ[(size_t)tt * NUP + cv]); } }
    ACT[(size_t)(row0 + t) * FF + j] = (bf16_t)(pg8::cvt_pk_bf16(silu_f(g) * v, 0.f) & 0xffff);
}
__global__ void __launch_bounds__(256) k_final(float* out, const float* ssq, const float* g) {
    const int row = blockIdx.x; const float r = rsqrtf(ssq[row] * (1.0f / D_) + RMS_EPS);
    f32x4* o = (f32x4*)(out + (size_t)row * D_); const f32x4* gg = (const f32x4*)g;
    for (int i = threadIdx.x; i < D_ / 4; i += 256) o[i] = o[i] * r * gg[i];
}


typedef pg8::bf16x8 bf16x8;
typedef short s16x4_t __attribute__((ext_vector_type(4)));
__device__ __forceinline__ bf16x8 tr_pair(const LAS unsigned char* p0, const LAS unsigned char* p1) {
    const s16x4_t lo = __builtin_bit_cast(s16x4_t, __builtin_amdgcn_ds_read_tr16_b64_v4i16((LAS s16x4_t*)p0));
    const s16x4_t hi = __builtin_bit_cast(s16x4_t, __builtin_amdgcn_ds_read_tr16_b64_v4i16((LAS s16x4_t*)p1));
    return __builtin_shufflevector(lo, hi, 0, 1, 2, 3, 4, 5, 6, 7);
}
#define MFMA16(a, b, c) __builtin_amdgcn_mfma_f32_16x16x32_bf16((a), (b), (c), 0, 0, 0)

struct HgrnArgs { const bf16_t* QD; const bf16_t* KD; const float* EGL; const bf16_t* V; float* ORAW; float* SSQH; };
constexpr int HG_QS = 0, HG_KS = 17408, HG_VS = 34816, HG_PAR = 39936, HG_PS = 2 * HG_PAR, HG_ST = HG_PS + 9216, HG_END = HG_ST + 8704;
__device__ __forceinline__ void hgrn_unit(const HgrnArgs& a, LAS unsigned char* lds, int unit) {
    const int tid = threadIdx.x, lane = tid & 63, w = __builtin_amdgcn_readfirstlane(tid >> 6), li = lane & 15, q4 = lane >> 4;
    const int b = unit >> 5, h = (unit >> 2) & 7, dq = unit & 3;
    const size_t rowbase = (size_t)b * L_;
    const int colq = h * 128, colv = h * 128 + dq * 32;
    for (int i = tid; i < 8704 / 4; i += 512) ((LAS unsigned*)(lds + HG_ST))[i] = 0u;
    u32x4 rq[2], rk[2], rv = (u32x4){0u, 0u, 0u, 0u};
#define HG_LOAD(c) do { const size_t r0 = rowbase + (size_t)(c) * 64; _Pragma("unroll") for (int i = 0; i < 2; ++i) { const int idx = tid + 512 * i, row = idx >> 4, c16 = idx & 15; \
        rq[i] = *(const u32x4*)(a.QD + (r0 + row) * HW + colq + c16 * 8); rk[i] = *(const u32x4*)(a.KD + (r0 + row) * HW + colq + c16 * 8); } \
        if (tid < 256) rv = *(const u32x4*)(a.V + (r0 + (tid >> 2)) * HW + colv + (tid & 3) * 8); } while (0)
#define HG_WRITE(p) do { _Pragma("unroll") for (int i = 0; i < 2; ++i) { const int idx = tid + 512 * i, row = idx >> 4, c16 = idx & 15; \
        *(LAS u32x4*)(lds + (p) * HG_PAR + HG_QS + (row * 136 + c16 * 8) * 2) = rq[i]; *(LAS u32x4*)(lds + (p) * HG_PAR + HG_KS + (row * 136 + c16 * 8) * 2) = rk[i]; } \
        if (tid < 256) *(LAS u32x4*)(lds + (p) * HG_PAR + HG_VS + ((tid >> 2) * 40 + (tid & 3) * 8) * 2) = rv; } while (0)
    HG_LOAD(0); HG_WRITE(0);
    __syncthreads();
    f32x4 Sacc[2] = {(f32x4){0.f, 0.f, 0.f, 0.f}, (f32x4){0.f, 0.f, 0.f, 0.f}};
    for (int c = 0; c < 64; ++c) {
        const int p = c & 1;
        const LAS unsigned char* QS = lds + p * HG_PAR + HG_QS; const LAS unsigned char* KS = lds + p * HG_PAR + HG_KS; const LAS unsigned char* VS = lds + p * HG_PAR + HG_VS;
        if (c + 1 < 64) HG_LOAD(c + 1);
        const f32x4 egl4 = *(const f32x4*)(a.EGL + (size_t)(b * 64 + c) * HW + colq + w * 16 + 4 * q4);
#pragma unroll
        for (int tt = 0; tt < 2; ++tt) { const int t = 2 * w + tt, sb = t >> 2, tb = t & 3; f32x4 acc = (f32x4){0.f, 0.f, 0.f, 0.f};
            if (sb <= tb) {
#pragma unroll
                for (int ks = 0; ks < 4; ++ks) { const bf16x8 A = *(const LAS bf16x8*)(KS + ((sb * 16 + li) * 136 + ks * 32 + 8 * q4) * 2), B = *(const LAS bf16x8*)(QS + ((tb * 16 + li) * 136 + ks * 32 + 8 * q4) * 2); acc = MFMA16(A, B, acc); } }
            const int s0 = sb * 16 + 4 * q4, tq = tb * 16 + li; float m[4];
#pragma unroll
            for (int r = 0; r < 4; ++r) m[r] = (s0 + r <= tq) ? acc[r] : 0.f;
            u32x2 o; o.x = pg8::cvt_pk_bf16(m[0], m[1]); o.y = pg8::cvt_pk_bf16(m[2], m[3]);
            *(LAS u32x2*)(lds + HG_PS + (tq * 72 + s0) * 2) = o; }
        __syncthreads();
        { const int tb = w >> 1, nb = w & 1; f32x4 acc = (f32x4){0.f, 0.f, 0.f, 0.f};
#pragma unroll
            for (int ks = 0; ks < 2; ++ks) { const bf16x8 A = *(const LAS bf16x8*)(lds + HG_PS + ((tb * 16 + li) * 72 + ks * 32 + 8 * q4) * 2);
                const LAS unsigned char* vp = VS + ((ks * 32 + 8 * q4 + (li >> 2)) * 40 + nb * 16 + 4 * (li & 3)) * 2; const bf16x8 B = tr_pair(vp, vp + 4 * 40 * 2); acc = MFMA16(A, B, acc); }
#pragma unroll
            for (int ks = 0; ks < 4; ++ks) { const bf16x8 A = *(const LAS bf16x8*)(QS + ((tb * 16 + li) * 136 + ks * 32 + 8 * q4) * 2), B = *(const LAS bf16x8*)(lds + HG_ST + ((nb * 16 + li) * 136 + ks * 32 + 8 * q4) * 2); acc = MFMA16(A, B, acc); }
            const size_t r0 = rowbase + (size_t)c * 64 + tb * 16 + 4 * q4;
#pragma unroll
            for (int r = 0; r < 4; ++r) { a.ORAW[(r0 + r) * HW + colv + nb * 16 + li] = acc[r]; float s = acc[r] * acc[r]; s += __shfl_xor(s, 1); s += __shfl_xor(s, 2); s += __shfl_xor(s, 4); s += __shfl_xor(s, 8);
                if (li == 0) a.SSQH[((r0 + r) * 8 + h) * 8 + dq * 2 + nb] = s; } }
#pragma unroll
        for (int nb = 0; nb < 2; ++nb) { f32x4 acc = Sacc[nb];
#pragma unroll
            for (int ks = 0; ks < 2; ++ks) { const LAS unsigned char* kp = KS + ((ks * 32 + 8 * q4 + (li >> 2)) * 136 + w * 16 + 4 * (li & 3)) * 2; const bf16x8 A = tr_pair(kp, kp + 4 * 136 * 2);
                const LAS unsigned char* vp = VS + ((ks * 32 + 8 * q4 + (li >> 2)) * 40 + nb * 16 + 4 * (li & 3)) * 2; const bf16x8 B = tr_pair(vp, vp + 4 * 40 * 2); acc = MFMA16(A, B, acc); }
            Sacc[nb] = acc * egl4; }
        __syncthreads();
#pragma unroll
        for (int nb = 0; nb < 2; ++nb) { u32x2 o; o.x = pg8::cvt_pk_bf16(Sacc[nb][0], Sacc[nb][1]); o.y = pg8::cvt_pk_bf16(Sacc[nb][2], Sacc[nb][3]); *(LAS u32x2*)(lds + HG_ST + ((nb * 16 + li) * 136 + w * 16 + 4 * q4) * 2) = o; }
        if (c + 1 < 64) HG_WRITE(p ^ 1);
        __syncthreads();
    }
#undef HG_LOAD
#undef HG_WRITE
}
__device__ __forceinline__ void oh_rows(const float* ORAW, const float* SSQH, const bf16_t* G, const float* norm_g, bf16_t* OH, int gw, int ngw, int lane) {
    for (int row = gw; row < T_; row += ngw) { const int hcol = lane * 16, h = lane >> 3; const size_t o = (size_t)row * HW + hcol;
        const f32x4 p0 = *(const f32x4*)(SSQH + ((size_t)row * 8 + h) * 8), p1 = *(const f32x4*)(SSQH + ((size_t)row * 8 + h) * 8 + 4);
        const float r = rsqrtf(((p0[0] + p0[1]) + (p0[2] + p0[3]) + (p1[0] + p1[1]) + (p1[2] + p1[3])) * (1.0f / 128.0f) + RMS_EPS);
#pragma unroll
        for (int hh = 0; hh < 2; ++hh) { const f32x4 a0 = *(const f32x4*)(ORAW + o + hh * 8), a1 = *(const f32x4*)(ORAW + o + hh * 8 + 4), n0 = *(const f32x4*)(norm_g + hcol + hh * 8), n1 = *(const f32x4*)(norm_g + hcol + hh * 8 + 4);
            float g[8], v[8]; unpack8(*(const u32x4*)(G + o + hh * 8), g);
#pragma unroll
            for (int j = 0; j < 4; ++j) { v[j] = a0[j] * r * n0[j] * g[j]; v[4 + j] = a1[j] * r * n1[j] * g[4 + j]; }
            *(u32x4*)(OH + o + hh * 8) = pack8(v); } }
}

constexpr int S5_KT = 0, S5_E = 9216, S5_F = S5_E + 65536, S5_AB = S5_F + 65536, S5_GSTRIDE = S5_AB + 512;
struct S5In { const float *a_re, *a_im, *log_dt, *b_re, *b_im, *c_re, *c_im, *d; };
__device__ __forceinline__ void s5_tables(const S5In& in, unsigned char* tabs, LAS unsigned char* lds, int g) {
    const int tid = threadIdx.x;
    LAS float* PWr = (LAS float*)lds; LAS float* PWi = PWr + 17 * 64; LAS float* Bcr = PWi + 17 * 64; LAS float* Bci = Bcr + 1024; LAS float* Ccr = Bci + 1024; LAS float* Cci = Ccr + 1024;
    unsigned char* tab = tabs + (size_t)g * S5_GSTRIDE;
    if (tid < 64) { const int p = tid; const float lr = fminf(in.a_re[g * 64 + p], -1e-4f), li = in.a_im[g * 64 + p], dt = __expf(in.log_dt[g]), th = li * dt, mm = lr * dt;
        for (int j = 0; j <= 16; ++j) { float sn, cs; sincos_rev(th * (float)j, sn, cs); const float mag = __expf(mm * (float)j); PWr[j * 64 + p] = mag * cs; PWi[j * 64 + p] = mag * sn; }
        const float abr = PWr[64 + p], abi = PWi[64 + p], den = lr * lr + li * li, nr = abr - 1.0f, ni = abi, cr = (nr * lr + ni * li) / den, ci = (ni * lr - nr * li) / den;
        for (int c = 0; c < 16; ++c) { const float br = in.b_re[(g * 64 + p) * 16 + c], bi = in.b_im[(g * 64 + p) * 16 + c]; Bcr[p * 16 + c] = cr * br - ci * bi; Bci[p * 16 + c] = cr * bi + ci * br; }
        ((float*)(tab + S5_AB))[2 * p] = PWr[16 * 64 + p]; ((float*)(tab + S5_AB))[2 * p + 1] = PWi[16 * 64 + p]; }
    for (int i = tid; i < 1024; i += 512) { Ccr[i] = in.c_re[g * 1024 + i]; Cci[i] = in.c_im[g * 1024 + i]; }
    __syncthreads();
    bf16_t* KT = (bf16_t*)(tab + S5_KT); bf16_t* E = (bf16_t*)(tab + S5_E); bf16_t* F = (bf16_t*)(tab + S5_F);
    if (tid < 256) KT[tid] = 0;
    for (int i = 0; i < 8; ++i) { const int e = tid * 8 + i, tau = e >> 8, c = (e >> 4) & 15, cp = e & 15; float acc = 0.f;
        for (int p = 0; p < 64; ++p) { const float pr = PWr[tau * 64 + p], pi = PWi[tau * 64 + p], br = Bcr[p * 16 + cp], bi = Bci[p * 16 + cp]; const float wr_ = pr * br - pi * bi, wi_ = pr * bi + pi * br;
            acc += Ccr[c * 64 + p] * wr_ - Cci[c * 64 + p] * wi_; }
        if (tau == 0 && c == cp) acc += in.d[g * 16 + c];
        KT[256 + e] = (bf16_t)(pg8::cvt_pk_bf16(acc, 0.f) & 0xffff); }
    for (int i = 0; i < 64; ++i) { const int e = tid + 512 * i, r = e >> 8, k = e & 255, s = k >> 4, cp = k & 15, p = r & 63; const float pr = PWr[(15 - s) * 64 + p], pi = PWi[(15 - s) * 64 + p], br = Bcr[p * 16 + cp], bi = Bci[p * 16 + cp];
        E[e] = (bf16_t)(pg8::cvt_pk_bf16(r < 64 ? pr * br - pi * bi : pr * bi + pi * br, 0.f) & 0xffff); }
    for (int i = 0; i < 64; ++i) { const int e = tid + 512 * i, row = e >> 7, k = e & 127, t = row >> 4, c = row & 15, p = k & 63; const float pr = PWr[(t + 1) * 64 + p], pi = PWi[(t + 1) * 64 + p], cr = Ccr[c * 64 + p], ci = Cci[c * 64 + p];
        F[e] = (bf16_t)(pg8::cvt_pk_bf16(k < 64 ? cr * pr - ci * pi : -(cr * pi + ci * pr), 0.f) & 0xffff); }
    __syncthreads();
}
struct S5FArgs { const bf16_t* UG; const unsigned char* tabs; bf16_t* Z; };
constexpr int S5_US = 0, S5_EUS = 33792, S5_HS = 67584, S5_KTS = 84992, S5_LDS_END = 93696;
__device__ __forceinline__ void s5_unit(const S5FArgs& a, LAS unsigned char* lds, int unit) {
    const int tid = threadIdx.x, lane = tid & 63, w = __builtin_amdgcn_readfirstlane(tid >> 6), li = lane & 15, q4 = lane >> 4;
    const int b = unit >> 6, g = unit & 63;
    const unsigned char* tab = a.tabs + (size_t)g * S5_GSTRIDE;
    const bf16_t* E = (const bf16_t*)(tab + S5_E); const bf16_t* F = (const bf16_t*)(tab + S5_F);
    __syncthreads();
    for (int i = tid; i < 544; i += 512) *(LAS u32x4*)(lds + S5_KTS + i * 16) = *(const u32x4*)(tab + S5_KT + i * 16);
    bf16x8 Ef[8], Ff[2][4];
#pragma unroll
    for (int ks = 0; ks < 8; ++ks) Ef[ks] = *(const bf16x8*)(E + (w * 16 + li) * 256 + ks * 32 + 8 * q4);
#pragma unroll
    for (int tt = 0; tt < 2; ++tt) { const int t = tt ? 15 - w : w;
#pragma unroll
        for (int ks = 0; ks < 4; ++ks) Ff[tt][ks] = *(const bf16x8*)(F + (t * 16 + li) * 128 + ks * 32 + 8 * q4); }
    float hr = 0.f, hi = 0.f; const float abr = ((const float*)(tab + S5_AB))[2 * lane], abi = ((const float*)(tab + S5_AB))[2 * lane + 1];
    const bf16_t* U = a.UG + (size_t)(b * 64 + g) * L_ * 16;
    for (int seg = 0; seg < 4; ++seg) {
#pragma unroll
        for (int i = 0; i < 4; ++i) { const int idx = tid + 512 * i, n = idx >> 5, c16 = idx & 31; *(LAS u32x4*)(lds + S5_US + (n * 264 + c16 * 8) * 2) = *(const u32x4*)(U + (size_t)seg * 16384 + (size_t)idx * 8); }
        __syncthreads();
#pragma unroll
        for (int nb = 0; nb < 4; ++nb) { f32x4 acc = (f32x4){0.f, 0.f, 0.f, 0.f};
#pragma unroll
            for (int ks = 0; ks < 8; ++ks) { const bf16x8 B = *(const LAS bf16x8*)(lds + S5_US + ((nb * 16 + li) * 264 + ks * 32 + 8 * q4) * 2); acc = MFMA16(Ef[ks], B, acc); }
            *(LAS f32x4*)(lds + S5_EUS + ((nb * 16 + li) * 132 + w * 16 + 4 * q4) * 4) = acc; }
        __syncthreads();
        if (w == 0) {
#pragma unroll 8
            for (int n = 0; n < 64; ++n) { const float er = *(const LAS float*)(lds + S5_EUS + (n * 132 + lane) * 4), ei = *(const LAS float*)(lds + S5_EUS + (n * 132 + 64 + lane) * 4);
                *(LAS bf16_t*)(lds + S5_HS + (n * 136 + lane) * 2) = (bf16_t)(pg8::cvt_pk_bf16(hr, 0.f) & 0xffff); *(LAS bf16_t*)(lds + S5_HS + (n * 136 + 64 + lane) * 2) = (bf16_t)(pg8::cvt_pk_bf16(hi, 0.f) & 0xffff);
                const float nhr = abr * hr - abi * hi + er, nhi = abr * hi + abi * hr + ei; hr = nhr; hi = nhi; } }
        __syncthreads();
#pragma unroll
        for (int tt = 0; tt < 2; ++tt) { const int t = tt ? 15 - w : w;
#pragma unroll
            for (int nb = 0; nb < 4; ++nb) { f32x4 acc = (f32x4){0.f, 0.f, 0.f, 0.f};
                for (int ks = 0; ks <= (t >> 1); ++ks) { const int ti = t - 2 * ks - (q4 >> 1) + 1; const bf16x8 A = *(const LAS bf16x8*)(lds + S5_KTS + (ti * 256 + li * 16 + 8 * (q4 & 1)) * 2);
                    const bf16x8 B = *(const LAS bf16x8*)(lds + S5_US + ((nb * 16 + li) * 264 + ks * 32 + 8 * q4) * 2); acc = MFMA16(A, B, acc); }
#pragma unroll
                for (int ks = 0; ks < 4; ++ks) { const bf16x8 B = *(const LAS bf16x8*)(lds + S5_HS + ((nb * 16 + li) * 136 + ks * 32 + 8 * q4) * 2); acc = MFMA16(Ff[tt][ks], B, acc); }
                const size_t tok = (size_t)b * L_ + seg * 1024 + (nb * 16 + li) * 16 + t; u32x2 o; o.x = pg8::cvt_pk_bf16(gelu_tanh_f(acc[0]), gelu_tanh_f(acc[1])); o.y = pg8::cvt_pk_bf16(gelu_tanh_f(acc[2]), gelu_tanh_f(acc[3]));
                *(u32x2*)(a.Z + tok * W5 + g * 16 + 4 * q4) = o; } }
        __syncthreads();
    }
}
__global__ void __launch_bounds__(512, 2) k_hgrn_fast(HgrnArgs a) { extern __shared__ __attribute__((aligned(16))) unsigned char lds[]; for (int u = blockIdx.x; u < 128; u += gridDim.x) { hgrn_unit(a, (LAS unsigned char*)lds, u); __syncthreads(); } }
__global__ void __launch_bounds__(512, 2) k_s5_fast(S5FArgs a) { extern __shared__ __attribute__((aligned(16))) unsigned char lds[]; for (int u = blockIdx.x; u < 256; u += gridDim.x) s5_unit(a, (LAS unsigned char*)lds, u); }
__global__ void __launch_bounds__(512, 2) k_s5_tab(S5In in, unsigned char* tabs) { extern __shared__ __attribute__((aligned(16))) unsigned char lds[]; s5_tables(in, tabs, (LAS unsigned char*)lds, blockIdx.x); }
__global__ void __launch_bounds__(512, 2) k_oh_fast(const float* ORAW, const float* SSQH, const bf16_t* G, const float* norm_g, bf16_t* OH) { oh_rows(ORAW, SSQH, G, norm_g, OH, blockIdx.x * 8 + (threadIdx.x >> 6), gridDim.x * 8, threadIdx.x & 63); }

__host__ __device__ __forceinline__ pg8::Gemm mk_gemm(const void* A, const void* Bt, int M, int N, int K) { pg8::Gemm g{}; g.A = g.A2 = (const bf16_t*)A; g.Bt = g.Bt2 = (const bf16_t*)Bt; g.M = M; g.N = N; g.K = K; return g; }

#define XB_TMO      128
#define XB_XCNT(j)  (256  + 64 * (j))
#define XB_XSUB(j)  (1280 + 64 * (j))
#define XB_XGEN(j)  (2304 + 64 * (j))
#define XB_TOP      3328
#define XB_TOPGEN   3392
#define XCD_BAR_WORDS 3456
#define XB_SPIN_CAP (1u << 18)
__device__ __forceinline__ unsigned xb_ld(unsigned* p)              { return __hip_atomic_load(p, __ATOMIC_RELAXED, __HIP_MEMORY_SCOPE_AGENT); }
__device__ __forceinline__ unsigned xb_add(unsigned* p, unsigned v) { return __hip_atomic_fetch_add(p, v, __ATOMIC_RELAXED, __HIP_MEMORY_SCOPE_AGENT); }
__device__ __forceinline__ unsigned xb_xcc_id() { return (unsigned)__builtin_amdgcn_s_getreg((3 << 11) | 20) & 0xFu; }
#define XB_SPIN(cond, bar) do { unsigned _sp = 0; while (cond) { __builtin_amdgcn_s_sleep(1); \
    if ((++_sp & 255u) == 0u) { if (xb_ld(&(bar)[XB_TMO])) break; if (_sp > XB_SPIN_CAP) { atomicAdd(&(bar)[XB_TMO], 1u); break; } } } } while (0)
struct XcdBarrier { unsigned* bar; unsigned x; volatile LAS unsigned* st; };
__device__ __forceinline__ XcdBarrier xcd_barrier_post(unsigned* bar, volatile LAS unsigned* st) {
    XcdBarrier b; b.bar = bar; b.x = xb_xcc_id(); b.st = st;
    if (threadIdx.x == 0) (void)xb_add(&bar[XB_XCNT(b.x)], 1u);
    return b;
}
__device__ __forceinline__ void xcd_barrier_complete(unsigned* bar, unsigned x, unsigned& nloc, unsigned& nx) {
    const unsigned G = gridDim.x * gridDim.y * gridDim.z;
    unsigned sum, cnt, mine, sp = 0u;
    for (;;) {
        sum = 0u; cnt = 0u; mine = 0u;
#pragma unroll
        for (unsigned j = 0; j < 16; ++j) { const unsigned c = xb_ld(&bar[XB_XCNT(j)]); sum += c; cnt += (c > 0u) ? 1u : 0u; mine = (j == x) ? c : mine; }
        if (sum == G) break;
        __builtin_amdgcn_s_sleep(1);
        if ((++sp & 255u) == 0u) { if (xb_ld(&bar[XB_TMO])) break; if (sp > XB_SPIN_CAP) { atomicAdd(&bar[XB_TMO], 1u); break; } }
    }
    nloc = mine > 0u ? mine : 1u; nx = cnt > 0u ? cnt : 1u;
}
__device__ __forceinline__ void xcd_barrier(const XcdBarrier& b) {
    asm volatile("s_waitcnt vmcnt(0)" ::: "memory");
    __syncthreads();
    if (threadIdx.x == 0) {
        unsigned* bar = b.bar;
        __builtin_amdgcn_s_waitcnt(0);
        unsigned nloc = b.st[0], nx = b.st[1];
        if (nloc == 0u) { xcd_barrier_complete(bar, b.x, nloc, nx); b.st[0] = nloc; b.st[1] = nx; }
        const unsigned old = xb_add(&bar[XB_XSUB(b.x)], 1u);
        const unsigned gen = old / nloc;
        if (old + 1u == (gen + 1u) * nloc) {
            __builtin_amdgcn_fence(__ATOMIC_RELEASE, "agent");
            asm volatile("s_waitcnt vmcnt(0)" ::: "memory");
            const unsigned og = xb_add(&bar[XB_TOP], 1u);
            const unsigned tg = og / nx;
            if (og + 1u == (tg + 1u) * nx) xb_add(&bar[XB_TOPGEN], 1u);
            else XB_SPIN(xb_ld(&bar[XB_TOPGEN]) == tg, bar);
            __builtin_amdgcn_fence(__ATOMIC_ACQUIRE, "agent");
            xb_add(&bar[XB_XGEN(b.x)], 1u);
            asm volatile("s_waitcnt vmcnt(0)" ::: "memory");
        } else {
            XB_SPIN(xb_ld(&bar[XB_XGEN(b.x)]) == gen, bar);
            __builtin_amdgcn_fence(__ATOMIC_ACQUIRE, "agent");
            asm volatile("s_waitcnt vmcnt(0)" ::: "memory");
        }
    }
    __syncthreads();
}
constexpr int CW_BAR = 4096;
constexpr int MISC_OFF = 131072;
#ifndef N_CG_SYNC
#define N_CG_SYNC 1
#endif
struct MegaArgs { const float* in[24]; float* out; unsigned char* ws; };
__global__ void __launch_bounds__(512, 2) k_mega(MegaArgs a) {
    extern __shared__ __attribute__((aligned(16))) unsigned char lds_[];
    LAS unsigned char* lds = (LAS unsigned char*)lds_;
    cg::grid_group grid = cg::this_grid();
    volatile LAS unsigned* misc = (volatile LAS unsigned*)(lds + MISC_OFF);
    if (threadIdx.x < 64) misc[threadIdx.x] = 0u;
    __syncthreads();
    unsigned char* ws = a.ws; float* out = a.out;
    XcdBarrier bar = xcd_barrier_post((unsigned*)(ws + WS_CTL) + CW_BAR, misc + 8);
    int seam = 0;
#define SEAM() do { if (seam < N_CG_SYNC) grid.sync(); else xcd_barrier(bar); ++seam; } while (0)
    const float *x = a.in[0], *ln_mix_g = a.in[1], *w_in = a.in[2], *a_re = a.in[3], *a_im = a.in[4], *log_dt = a.in[5], *b_re = a.in[6], *b_im = a.in[7], *c_re = a.in[8], *c_im = a.in[9], *s5d = a.in[10], *w_glu = a.in[11], *b_glu = a.in[12],
                *w_ps5 = a.in[13], *lb_logits = a.in[14], *norm_g = a.in[15], *w_ph = a.in[16], *w_out = a.in[17], *ln_ffn_g = a.in[18], *w_up = a.in[19], *conv_w = a.in[20], *conv_b = a.in[21], *w_down = a.in[22], *ln_final_g = a.in[23];
    float* SSQ2 = (float*)(ws + CTL_SSQ2); float* SSQ3 = (float*)(ws + CTL_SSQ3);
    bf16_t* GS5 = (bf16_t*)out; bf16_t* GH = GS5 + (size_t)T_ * D_;
    const int G = (int)gridDim.x, bx = (int)blockIdx.x, wave = __builtin_amdgcn_readfirstlane((int)(threadIdx.x >> 6)), lane = (int)(threadIdx.x & 63);
    if (bx >= G - 64) { S5In in{}; in.a_re = a_re; in.a_im = a_im; in.log_dt = log_dt; in.b_re = b_re; in.b_im = b_im; in.c_re = c_re; in.c_im = c_im; in.d = s5d; s5_tables(in, ws + WS_S5TAB, lds, bx - (G - 64)); }
    { PrepArgs p{}; p.x = x; p.ln_mix_g = ln_mix_g; p.w_in = w_in; p.w_glu = w_glu; p.w_ps5 = w_ps5; p.w_ph = w_ph; p.w_out = w_out; p.ln_ffn_g = ln_ffn_g; p.w_up = w_up; p.w_down = w_down; p.lb_logits = lb_logits; p.ws = ws;
      prep_phase(p, lds, bx * 8 + wave, G * 8, lane); }
    SEAM();
    { EpiProjF E{}; E.rstd = (const float*)(ws + WS_RSTD1); E.lb = (const float*)(ws + WS_LB); E.UG = (bf16_t*)(ws + WS_UG); E.QD = (bf16_t*)(ws + WS_QD); E.KD = (bf16_t*)(ws + WS_KD); E.V = (bf16_t*)(ws + WS_V);
      E.G = (bf16_t*)(ws + WS_G); E.GS5 = GS5; E.GH = GH; E.EGL = (float*)(ws + WS_EGL);
      const pg8::Gemm g = mk_gemm(ws + WS_XB, ws + WS_WIN, T_, NIN, D_); pg8::StaticOrder S; S.init(g.M, g.N, G, bx); pg8::gemm_phase<EpiProjF, pg8::StaticOrder, true, true>(lds, g, S, E); }
    SEAM();
    if (bx < 128) { HgrnArgs h{}; h.QD = (const bf16_t*)(ws + WS_QD); h.KD = (const bf16_t*)(ws + WS_KD); h.EGL = (const float*)(ws + WS_EGL); h.V = (const bf16_t*)(ws + WS_V); h.ORAW = (float*)(ws + WS_ORAW); h.SSQH = (float*)(ws + WS_SSQH);
        for (int u = bx; u < 128; u += 128) hgrn_unit(h, lds, u); }
    else { S5FArgs s{}; s.UG = (const bf16_t*)(ws + WS_UG); s.tabs = ws + WS_S5TAB; s.Z = (bf16_t*)(ws + WS_Z);
        for (int u = bx - 128; u < 256; u += G - 128) s5_unit(s, lds, u); }
    SEAM();
    oh_rows((const float*)(ws + WS_ORAW), (const float*)(ws + WS_SSQH), (const bf16_t*)(ws + WS_G), norm_g, (bf16_t*)(ws + WS_OH), bx * 8 + wave, G * 8, lane);
    { EpiGlu E{}; E.Z = (const bf16_t*)(ws + WS_Z); E.bias = b_glu; E.ZS = (bf16_t*)(ws + WS_ZS);
      const pg8::Gemm g = mk_gemm(ws + WS_Z, ws + WS_WGLU, T_, W5, W5); pg8::StaticOrder S; S.init(g.M, g.N, G, bx); pg8::gemm_phase<EpiGlu, pg8::StaticOrder, true, true>(lds, g, S, E); }
    SEAM();
    { EpiMerged E{}; E.GS5 = GS5; E.GH = GH; E.MERGED = (bf16_t*)(ws + WS_MERGED);
      pg8::Gemm g = mk_gemm(ws + WS_ZS, ws + WS_WPS5, T_, D_, W5); g.A2 = (const bf16_t*)(ws + WS_OH); g.Bt2 = (const bf16_t*)(ws + WS_WPH);
      pg8::PairOrder S; S.init(g.M, g.N, G, bx); pg8::gemm_phase<EpiMerged, pg8::PairOrder, true, true>(lds, g, S, E); }
    SEAM();
    { EpiRes E{}; E.XI = x; E.XO = out; E.XBF = (bf16_t*)(ws + WS_X1B); E.ssq = SSQ2;
      const pg8::Gemm g = mk_gemm(ws + WS_MERGED, ws + WS_WOUT, T_, D_, D_); pg8::StaticOrder S; S.init(g.M, g.N, G, bx); pg8::gemm_phase<EpiRes, pg8::StaticOrder, true, true>(lds, g, S, E); }
    SEAM();
    { EpiUpConv E{}; E.ssq = SSQ2; E.cw = conv_w; E.cb = conv_b; E.ACT = (bf16_t*)(ws + WS_ACT); E.RAW = (float*)(ws + WS_RAW);
      const pg8::Gemm g = mk_gemm(ws + WS_X1B, ws + WS_WUP, T_, NUP, D_); pg8::StaticOrder S; S.init(g.M, g.N, G, bx); pg8::gemm_phase<EpiUpConv, pg8::StaticOrder, true, true>(lds, g, S, E); }
    SEAM();
    { const pg8::Gemm g = mk_gemm(ws + WS_ACT, ws + WS_WDOWN, T_, D_, FF); pg8::StaticOrder S; S.init(g.M, g.N, G, bx);
      int last_pm = -1; pg8::Unit u;
      for (int i = 0; S.next(i, u); ++i) if (u.pm != last_pm) { conv_fixup((const float*)(ws + WS_RAW), conv_w, conv_b, (bf16_t*)(ws + WS_ACT), 4 * u.pm, 4, (int)threadIdx.x, 512); last_pm = u.pm; }
      asm volatile("s_waitcnt vmcnt(0)" ::: "memory"); __syncthreads();
      EpiRes E{}; E.XI = out; E.XO = out; E.XBF = nullptr; E.ssq = SSQ3;
      pg8::gemm_phase<EpiRes, pg8::StaticOrder, true, true>(lds, g, S, E); }
    SEAM();
    for (int row = bx * 8 + wave; row < T_; row += G * 8) { const float r = rsqrtf(SSQ3[row] * (1.0f / D_) + RMS_EPS); f32x4* o = (f32x4*)(out + (size_t)row * D_) + lane; const f32x4* gg = (const f32x4*)ln_final_g + lane;
#pragma unroll
        for (int j = 0; j < 8; ++j) o[64 * j] = o[64 * j] * r * gg[64 * j]; }
#undef SEAM
}

#ifndef DBG_STOP
#define DBG_STOP 0
#endif
#ifndef USE_FAST_HGRN
#define USE_FAST_HGRN 1
#endif
#ifndef USE_FUSED_CUMSUM
#define USE_FUSED_CUMSUM 1
#endif
#ifndef USE_FUSED_CONV
#define USE_FUSED_CONV 1
#endif
#ifndef USE_MEGA
#define USE_MEGA 1
#endif
#ifndef USE_FAST_S5
#define USE_FAST_S5 1
#endif
__global__ void k_dump_bf16(const bf16_t* src, size_t n, float* out) { for (size_t i = (size_t)blockIdx.x * blockDim.x + threadIdx.x; i < (size_t)T_ * D_; i += (size_t)gridDim.x * blockDim.x) out[i] = bf2f(src[i % n]); }
__global__ void k_dump_f32(const float* src, size_t n, float* out) { for (size_t i = (size_t)blockIdx.x * blockDim.x + threadIdx.x; i < (size_t)T_ * D_; i += (size_t)gridDim.x * blockDim.x) out[i] = src[i % n]; }
#define DUMP_BF16(stage, off, n) do { if (DBG_STOP == (stage)) { hipLaunchKernelGGL(k_dump_bf16, dim3(2048), dim3(256), 0, stream, (const bf16_t*)(ws + (off)), (size_t)(n), out); return; } } while (0)
#define DUMP_F32(stage, off, n) do { if (DBG_STOP == (stage)) { hipLaunchKernelGGL(k_dump_f32, dim3(2048), dim3(256), 0, stream, (const float*)(ws + (off)), (size_t)(n), out); return; } } while (0)
constexpr int LDS_BYTES = 147456;
template <class Epi> static void launch_gemm(const pg8::Gemm& g, const Epi& E, int grid, hipStream_t s) {
    static bool once = false; if (!once) { (void)hipFuncSetAttribute((const void*)k_gemm<Epi>, hipFuncAttributeMaxDynamicSharedMemorySize, LDS_BYTES); once = true; }
    hipLaunchKernelGGL(k_gemm<Epi>, dim3(grid), dim3(512), LDS_BYTES, s, g, E);
}

extern "C" void kernel_launch(void* const* d_in, const int* in_sizes, int n_in, void* d_out, int out_size, void* d_ws, size_t ws_size, hipStream_t stream) {
    static int grid = 0;
    if (grid == 0) { int dev = 0, cus = 0; (void)hipGetDevice(&dev); (void)hipDeviceGetAttribute(&cus, hipDeviceAttributeMultiprocessorCount, dev); grid = cus > 0 ? cus : 256;
        (void)hipFuncSetAttribute((const void*)k_prep, hipFuncAttributeMaxDynamicSharedMemorySize, LDS_BYTES);
        (void)hipFuncSetAttribute((const void*)k_gemm_pair, hipFuncAttributeMaxDynamicSharedMemorySize, LDS_BYTES);
        (void)hipFuncSetAttribute((const void*)k_hgrn_fast, hipFuncAttributeMaxDynamicSharedMemorySize, LDS_BYTES); (void)hipFuncSetAttribute((const void*)k_s5_fast, hipFuncAttributeMaxDynamicSharedMemorySize, LDS_BYTES); (void)hipFuncSetAttribute((const void*)k_s5_tab, hipFuncAttributeMaxDynamicSharedMemorySize, LDS_BYTES);
        if (ws_size < 512 * MiB) fprintf(stderr, "kernel_launch: workspace %zu < 512 MiB\n", ws_size); }
#if USE_MEGA
    { static int mgrid = 0;
      if (mgrid == 0) { int per_cu = 0; (void)hipFuncSetAttribute((const void*)k_mega, hipFuncAttributeMaxDynamicSharedMemorySize, LDS_BYTES);
          (void)hipOccupancyMaxActiveBlocksPerMultiprocessor(&per_cu, (const void*)k_mega, 512, LDS_BYTES); if (per_cu < 1) per_cu = 1; mgrid = grid * per_cu; if (mgrid > 256) mgrid = 256;
          fprintf(stderr, "k_mega: cus %d per_cu %d grid %d\n", grid, per_cu, mgrid); }
      (void)hipMemsetAsync((unsigned char*)d_ws + WS_CTL, 0, 1 * MiB, stream);
      MegaArgs a{}; for (int i = 0; i < 24; ++i) a.in[i] = (const float*)d_in[i]; a.out = (float*)d_out; a.ws = (unsigned char*)d_ws;
      void* args[] = {&a};
      hipError_t e = hipLaunchCooperativeKernel((const void*)k_mega, dim3(mgrid), dim3(512), args, LDS_BYTES, stream);
      if (e != hipSuccess) fprintf(stderr, "cooperative launch failed: %s (grid %d)\n", hipGetErrorString(e), mgrid);
      return; }
#endif
    const float* const* in = (const float* const*)d_in;
    const float *x = in[0], *ln_mix_g = in[1], *w_in = in[2], *a_re = in[3], *a_im = in[4], *log_dt = in[5], *b_re = in[6], *b_im = in[7], *c_re = in[8], *c_im = in[9], *s5d = in[10], *w_glu = in[11], *b_glu = in[12],
                *w_ps5 = in[13], *lb_logits = in[14], *norm_g = in[15], *w_ph = in[16], *w_out = in[17], *ln_ffn_g = in[18], *w_up = in[19], *conv_w = in[20], *conv_b = in[21], *w_down = in[22], *ln_final_g = in[23];
    unsigned char* ws = (unsigned char*)d_ws; float* out = (float*)d_out;
    (void)hipMemsetAsync(ws + WS_CTL, 0, 1 * MiB, stream);
    float* SSQ2 = (float*)(ws + CTL_SSQ2); float* SSQ3 = (float*)(ws + CTL_SSQ3);
#ifdef DBG_GS5WS
    bf16_t* GS5 = (bf16_t*)(ws + WS_ORAW_NAIVE); bf16_t* GH = (bf16_t*)d_out + (size_t)T_ * D_;
#else
    bf16_t* GS5 = (bf16_t*)d_out; bf16_t* GH = GS5 + (size_t)T_ * D_;
#endif
    { PrepArgs a{}; a.x = x; a.ln_mix_g = ln_mix_g; a.w_in = w_in; a.w_glu = w_glu; a.w_ps5 = w_ps5; a.w_ph = w_ph; a.w_out = w_out; a.ln_ffn_g = ln_ffn_g; a.w_up = w_up; a.w_down = w_down; a.lb_logits = lb_logits; a.ws = ws;
      hipLaunchKernelGGL(k_prep, dim3(grid), dim3(512), LDS_BYTES, stream, a); }
    DUMP_BF16(13, WS_WIN, (size_t)NIN * D_);
#if USE_FUSED_CUMSUM
    { EpiProjF E{}; E.rstd = (const float*)(ws + WS_RSTD1); E.lb = (const float*)(ws + WS_LB); E.UG = (bf16_t*)(ws + WS_UG); E.QD = (bf16_t*)(ws + WS_QD); E.KD = (bf16_t*)(ws + WS_KD); E.V = (bf16_t*)(ws + WS_V);
      E.G = (bf16_t*)(ws + WS_G); E.GS5 = GS5; E.GH = GH; E.EGL = (float*)(ws + WS_EGL);
      launch_gemm(mk_gemm(ws + WS_XB, ws + WS_WIN, T_, NIN, D_), E, grid, stream); }
#else
    { EpiProj E{}; E.rstd = (const float*)(ws + WS_RSTD1); E.lb = (const float*)(ws + WS_LB); E.UG = (bf16_t*)(ws + WS_UG); E.SQ = (bf16_t*)(ws + WS_SQ); E.KKR = (bf16_t*)(ws + WS_KKR); E.V = (bf16_t*)(ws + WS_V);
      E.G = (bf16_t*)(ws + WS_G); E.GS5 = GS5; E.GH = GH; E.LOGF = (float*)(ws + WS_LOGF);
      launch_gemm(mk_gemm(ws + WS_XB, ws + WS_WIN, T_, NIN, D_), E, grid, stream); }
#endif
    DUMP_BF16(12, WS_ORAW_NAIVE, (size_t)T_ * D_);
    DUMP_BF16(1, WS_SQ, (size_t)T_ * HW); DUMP_BF16(2, WS_UG, (size_t)T_ * W5); DUMP_F32(3, WS_LOGF, (size_t)T_ * HW);
#if USE_FAST_S5
    { S5In in{}; in.a_re = a_re; in.a_im = a_im; in.log_dt = log_dt; in.b_re = b_re; in.b_im = b_im; in.c_re = c_re; in.c_im = c_im; in.d = s5d; hipLaunchKernelGGL(k_s5_tab, dim3(64), dim3(512), LDS_BYTES, stream, in, ws + WS_S5TAB);
      S5FArgs a{}; a.UG = (const bf16_t*)(ws + WS_UG); a.tabs = ws + WS_S5TAB; a.Z = (bf16_t*)(ws + WS_Z); hipLaunchKernelGGL(k_s5_fast, dim3(256), dim3(512), LDS_BYTES, stream, a); }
#else
    { S5Args a{}; a.UG = (const bf16_t*)(ws + WS_UG); a.a_re = a_re; a.a_im = a_im; a.log_dt = log_dt; a.b_re = b_re; a.b_im = b_im; a.c_re = c_re; a.c_im = c_im; a.d = s5d; a.Z = (bf16_t*)(ws + WS_Z);
      hipLaunchKernelGGL(k_s5_naive, dim3(256), dim3(64), 0, stream, a); }
#endif
#if USE_FAST_HGRN
#if !USE_FUSED_CUMSUM
    hipLaunchKernelGGL(k_cumsum, dim3(HW / 256, T_ / 64), dim3(256), 0, stream, (const bf16_t*)(ws + WS_SQ), (const float*)(ws + WS_LOGF), (const bf16_t*)(ws + WS_KKR), (bf16_t*)(ws + WS_QD), (bf16_t*)(ws + WS_KD), (float*)(ws + WS_EGL));
#endif
    { HgrnArgs a{}; a.QD = (const bf16_t*)(ws + WS_QD); a.KD = (const bf16_t*)(ws + WS_KD); a.EGL = (const float*)(ws + WS_EGL); a.V = (const bf16_t*)(ws + WS_V); a.ORAW = (float*)(ws + WS_ORAW); a.SSQH = (float*)(ws + WS_SSQH);
      hipLaunchKernelGGL(k_hgrn_fast, dim3(128), dim3(512), LDS_BYTES, stream, a); }
    hipLaunchKernelGGL(k_oh_fast, dim3(grid), dim3(512), 0, stream, (const float*)(ws + WS_ORAW), (const float*)(ws + WS_SSQH), (const bf16_t*)(ws + WS_G), norm_g, (bf16_t*)(ws + WS_OH));
#else
    hipLaunchKernelGGL(k_hgrn_naive, dim3(32), dim3(128), 0, stream, (const bf16_t*)(ws + WS_SQ), (const float*)(ws + WS_LOGF), (const bf16_t*)(ws + WS_KKR), (const bf16_t*)(ws + WS_V), (float*)(ws + WS_ORAW_NAIVE));
    hipLaunchKernelGGL(k_oh_naive, dim3(T_ * 8), dim3(64), 0, stream, (const float*)(ws + WS_ORAW_NAIVE), (const bf16_t*)(ws + WS_G), norm_g, (bf16_t*)(ws + WS_OH));
#endif
    if (DBG_STOP == 10) { (void)hipMemcpyAsync(ws + WS_MERGED, GH, (size_t)T_ * D_ * 2, hipMemcpyDeviceToDevice, stream); DUMP_BF16(10, WS_MERGED, (size_t)T_ * D_); }
    if (DBG_STOP == 11) { (void)hipMemcpyAsync(ws + WS_MERGED, GS5, (size_t)T_ * D_ * 2, hipMemcpyDeviceToDevice, stream); DUMP_BF16(11, WS_MERGED, (size_t)T_ * D_); }
    DUMP_BF16(4, WS_Z, (size_t)T_ * W5); DUMP_BF16(5, WS_OH, (size_t)T_ * HW);
    { EpiGlu E{}; E.Z = (const bf16_t*)(ws + WS_Z); E.bias = b_glu; E.ZS = (bf16_t*)(ws + WS_ZS); launch_gemm(mk_gemm(ws + WS_Z, ws + WS_WGLU, T_, W5, W5), E, grid, stream); }
    DUMP_BF16(6, WS_ZS, (size_t)T_ * W5);
    { EpiMerged E{}; E.GS5 = GS5; E.GH = GH; E.MERGED = (bf16_t*)(ws + WS_MERGED);
      pg8::Gemm g = mk_gemm(ws + WS_ZS, ws + WS_WPS5, T_, D_, W5); g.A2 = (const bf16_t*)(ws + WS_OH); g.Bt2 = (const bf16_t*)(ws + WS_WPH);
      hipLaunchKernelGGL(k_gemm_pair, dim3(grid), dim3(512), LDS_BYTES, stream, g, E); }
    DUMP_BF16(7, WS_MERGED, (size_t)T_ * D_);
    { EpiRes E{}; E.XI = x; E.XO = out; E.XBF = (bf16_t*)(ws + WS_X1B); E.ssq = SSQ2; launch_gemm(mk_gemm(ws + WS_MERGED, ws + WS_WOUT, T_, D_, D_), E, grid, stream); }
    if (DBG_STOP == 8) return;
#if USE_FUSED_CONV
    { EpiUpConv E{}; E.ssq = SSQ2; E.cw = conv_w; E.cb = conv_b; E.ACT = (bf16_t*)(ws + WS_ACT); E.RAW = (float*)(ws + WS_RAW); launch_gemm(mk_gemm(ws + WS_X1B, ws + WS_WUP, T_, NUP, D_), E, grid, stream);
      hipLaunchKernelGGL(k_conv_fixup, dim3(grid), dim3(512), 0, stream, (const float*)(ws + WS_RAW), conv_w, conv_b, (bf16_t*)(ws + WS_ACT)); }
#else
    for (int q = 0; q < 4; ++q) {
        EpiUpNaive E{}; E.ssq = SSQ2; E.UP = (bf16_t*)(ws + WS_UPQ); E.row0 = q * L_;
        launch_gemm(mk_gemm((bf16_t*)(ws + WS_X1B) + (size_t)q * L_ * D_, ws + WS_WUP, L_, NUP, D_), E, grid, stream);
        hipLaunchKernelGGL(k_conv_naive, dim3(FF / 256, L_), dim3(256), 0, stream, (const bf16_t*)(ws + WS_UPQ), conv_w, conv_b, (bf16_t*)(ws + WS_ACT), q * L_);
    }
    DUMP_BF16(9, WS_ACT, (size_t)T_ * FF);
#endif
    { EpiRes E{}; E.XI = out; E.XO = out; E.XBF = nullptr; E.ssq = SSQ3; launch_gemm(mk_gemm(ws + WS_ACT, ws + WS_WDOWN, T_, D_, FF), E, grid, stream); }
    hipLaunchKernelGGL(k_final, dim3(T_), dim3(256), 0, stream, out, (const float*)SSQ3, ln_final_g);
}
```

```cpp
#include <hip/hip_runtime.h>
#include <hip/hip_cooperative_groups.h>
namespace cg = cooperative_groups;
#include <cstdio>
#include <cstdint>
namespace pg8 {
#define PG8_LAS __attribute__((address_space(3)))
typedef unsigned short bf16_t;
typedef short bf16x8 __attribute__((ext_vector_type(8)));
typedef float f32x4 __attribute__((ext_vector_type(4)));
typedef unsigned u32x4 __attribute__((ext_vector_type(4)));
constexpr int BM = 256, BK = 64, HALF = 128, HTB = HALF * BK * 2  , STAGE_BYTES = 8 * HTB, NXCD = 8, WGM = 8;

__host__ __device__ __forceinline__ int lds_byte(int r, int c) { const int st = (r >> 4) * 2 + (c >> 5), rr = r & 15, cc = c & 31, ob = rr * 64 + cc * 2; return st * 1024 + (ob ^ (((ob >> 9) & 1) << 5)); }
__host__ __device__ __forceinline__ void stage_rc(int b, int& R, int& C) { const int st = b / 1024, sb = b % 1024, swz = sb ^ (((sb >> 9) & 1) << 5); R = (st >> 1) * 16 + swz / 64; C = (st & 1) * 32 + (swz % 64) / 2; }
__host__ __device__ __forceinline__ int perm32(int rho) { const int n = rho >> 4, i = rho & 15; return 8 * (i >> 2) + 4 * n + (i & 3); }

struct Unit { int pm, pn, seg; };
struct Gemm { const bf16_t* A; const bf16_t* Bt; const bf16_t* A2; const bf16_t* Bt2; int M, N, K, pad; };

struct StaticOrder {
    int nM, nN, nwg, G, c;
    __host__ __device__ void init(int M, int N, int G_, int c_) { nM = M / BM; nN = N / BM; nwg = nM * nN; G = G_; c = c_; }
    __host__ __device__ bool next(int i, Unit& u) const {
        const long L = (long)i * G + c; if (L >= nwg) return false;
        int wgid = (int)L; { const int q = nwg / NXCD, r = nwg % NXCD, xcd = wgid % NXCD, off = wgid / NXCD; wgid = (xcd < r ? xcd * (q + 1) : r * (q + 1) + (xcd - r) * q) + off; }
        const int nig = WGM * nN, gid = wgid / nig, fm = gid * WGM, gsz = (nM - fm) < WGM ? (nM - fm) : WGM;
        u.pm = fm + ((wgid % nig) % gsz); u.pn = (wgid % nig) / gsz; u.seg = 0; return true;
    }
    __device__ __forceinline__ void a_ready(const Unit&) const {}
    __device__ __forceinline__ void done(const Unit&) const {}
};
struct RangeOrder { int first, count, pn0;
    __host__ __device__ bool next(int i, Unit& u) const { if (i >= count) return false; const int id = first + i; u.pm = id >> 4; u.pn = pn0 + (id & 15); u.seg = 0; return true; }
    __device__ __forceinline__ void a_ready(const Unit&) const {}
    __device__ __forceinline__ void done(const Unit&) const {}
};
struct PanelOrder { int c;
    __host__ __device__ bool next(int i, Unit& u) const { if (i >= 2) return false; const int x = c & 7, k = c >> 3; u.pn = k & 7; u.pm = 8 * x + (k >> 3) + 4 * i; u.seg = 0; return true; }
    __device__ __forceinline__ void a_ready(const Unit&) const {}
    __device__ __forceinline__ void done(const Unit&) const {}
};
struct PairOrder : StaticOrder { __host__ __device__ bool next(int i, Unit& u) const { if (!StaticOrder::next(i >> 1, u)) return false; u.seg = i & 1; return true; } };

typedef float f32x2_cv __attribute__((ext_vector_type(2))); typedef __bf16 bf16x2_cv __attribute__((ext_vector_type(2)));
__device__ __forceinline__ unsigned cvt_pk_bf16(float lo, float hi) { f32x2_cv v = {lo, hi}; bf16x2_cv b = __builtin_convertvector(v, bf16x2_cv); return __builtin_bit_cast(unsigned, b); }
template <class Epi, class Sched, bool ALIGN_EPI = false, bool SP2 = false>
__device__ __forceinline__ void gemm_phase(PG8_LAS unsigned char* lds, const Gemm g, const Sched& S, const Epi& E) {
    int tid_ = threadIdx.x; asm volatile("" : "+v"(tid_));
    const int tid = tid_, wid = __builtin_amdgcn_readfirstlane(tid >> 6), lane = tid & 63, wr = wid >> 2, wc = wid & 3, fr = lane & 15, fq = lane >> 4;
    const int K = g.K, nt = K / BK;
    unsigned voffA[2], voffB[2];
#pragma unroll
    for (int i = 0; i < 2; ++i) { int R, C; stage_rc(tid * 16 + i * 8192, R, C); const int Rb = Epi::PERM ? ((R & ~31) + perm32(R & 31)) : R;
        voffA[i] = (unsigned)(R * K + C) * 2u; voffB[i] = (unsigned)(Rb * K + C) * 2u; }
    const size_t kstep = (size_t)(BK * 2);
    const size_t hstep = (size_t)HALF * K * 2;
    const size_t tstep = 2 * hstep;
    const unsigned ldsw = (unsigned)wid * 1024u;
    const int aoff = lds_byte(wr * 64 + fr, fq * 8), boff = lds_byte(wc * 32 + fr, fq * 8);
#define PG8_SA(b, h) (((b) * 2 + (h)) * HTB)
#define PG8_SB(b, h) ((4 + (b) * 2 + (h)) * HTB)
#define PG8_STAGE(bufoff, gbase, voff) do { _Pragma("unroll") for (int _i = 0; _i < 2; ++_i) \
        __builtin_amdgcn_global_load_lds((const unsigned*)((const char*)(gbase) + (voff)[_i]), (PG8_LAS unsigned*)(lds + (bufoff) + ldsw + _i * 8192), 16, 0, 0); } while (0)
#define PG8_LDA(dst, b, h) do { _Pragma("unroll") for (int m = 0; m < 4; ++m) _Pragma("unroll") for (int k = 0; k < 2; ++k) dst[m][k] = *(const PG8_LAS bf16x8*)(lds + PG8_SA(b, h) + aoff + m * 2048 + k * 1024); } while (0)
#define PG8_LDB(dst, b, h) do { _Pragma("unroll") for (int n = 0; n < 2; ++n) _Pragma("unroll") for (int k = 0; k < 2; ++k) dst[n][k] = *(const PG8_LAS bf16x8*)(lds + PG8_SB(b, h) + boff + n * 2048 + k * 1024); } while (0)
#define PG8_MMA(ai, bj, At, Bt) do { __builtin_amdgcn_s_setprio(1); _Pragma("unroll") for (int m = 0; m < 4; ++m) _Pragma("unroll") for (int n = 0; n < 2; ++n) _Pragma("unroll") for (int k = 0; k < 2; ++k) \
        acc[ai][bj][m][n] = __builtin_amdgcn_mfma_f32_16x16x32_bf16(Bt[n][k], At[m][k], acc[ai][bj][m][n], 0, 0, 0); __builtin_amdgcn_s_setprio(0); } while (0)
#define PG8_WAIT_V(n) asm volatile("s_waitcnt vmcnt(" #n ")" ::: "memory")
#define PG8_WAIT_L(n) asm volatile("s_waitcnt lgkmcnt(" #n ")" ::: "memory")
#define PG8_BAR __builtin_amdgcn_s_barrier()
#define PG8_SCHED __builtin_amdgcn_sched_barrier(0)
    Unit cur, nxt; int ui = 0;
    if (!S.next(0, cur)) return;
    f32x4 acc[2][2][4][2];
#pragma unroll
    for (int a = 0; a < 2; ++a)
#pragma unroll
        for (int b = 0; b < 2; ++b)
#pragma unroll
            for (int m = 0; m < 4; ++m)
#pragma unroll
                for (int n = 0; n < 2; ++n) acc[a][b][m][n] = (f32x4){0.f, 0.f, 0.f, 0.f};
    bf16x8 At[4][2], B0[2][2], B1[2][2];
    const char* cA = (const char*)(cur.seg ? g.A2 : g.A) + (size_t)cur.pm * tstep; const char* cB = (const char*)(cur.seg ? g.Bt2 : g.Bt) + (size_t)cur.pn * tstep;
    S.a_ready(cur);
    if constexpr (SP2) {
        PG8_STAGE(PG8_SB(0, 0), cB, voffB); PG8_STAGE(PG8_SB(0, 1), cB + hstep, voffB); PG8_STAGE(PG8_SA(0, 0), cA, voffA); PG8_STAGE(PG8_SA(0, 1), cA + hstep, voffA);
        if (wr == 1) PG8_BAR;
        PG8_WAIT_V(2); PG8_BAR;
        PG8_STAGE(PG8_SB(1, 0), cB + kstep, voffB); PG8_STAGE(PG8_SA(1, 0), cA + kstep, voffA); PG8_STAGE(PG8_SB(1, 1), cB + hstep + kstep, voffB);
        PG8_WAIT_V(6); PG8_BAR;
    } else {
        PG8_STAGE(PG8_SB(0, 0), cB, voffB); PG8_STAGE(PG8_SA(0, 0), cA, voffA); PG8_STAGE(PG8_SB(0, 1), cB + hstep, voffB); PG8_STAGE(PG8_SA(0, 1), cA + hstep, voffA);
        if (wr == 1) PG8_BAR;
        PG8_WAIT_V(4); PG8_BAR;
        PG8_STAGE(PG8_SB(1, 0), cB + kstep, voffB); PG8_STAGE(PG8_SA(1, 0), cA + kstep, voffA); PG8_STAGE(PG8_SB(1, 1), cB + hstep + kstep, voffB);
        PG8_WAIT_V(6); PG8_BAR;
    }
    for (;;) {
        const bool has_next = S.next(ui + 1, nxt);
        const char* nA = has_next ? (const char*)(nxt.seg ? g.A2 : g.A) + (size_t)nxt.pm * tstep : cA; const char* nB = has_next ? (const char*)(nxt.seg ? g.Bt2 : g.Bt) + (size_t)nxt.pn * tstep : cB;
        for (int t = 0; t < nt; t += 2) {
            const bool last = (t == nt - 2);
            const char* a1 = cA + (size_t)(t + 1) * kstep;
            const char* a2 = last ? nA : cA + (size_t)(t + 2) * kstep; const char* b2 = last ? nB : cB + (size_t)(t + 2) * kstep;
            const char* a3 = a2 + kstep; const char* b3 = b2 + kstep;
            if (last && has_next) S.a_ready(nxt);
            if constexpr (SP2) {
            PG8_LDB(B0, 0, 0); PG8_LDB(B1, 0, 1); PG8_SCHED; PG8_LDA(At, 0, 0); PG8_STAGE(PG8_SA(1, 1), a1 + hstep, voffA);
            PG8_WAIT_V(8); PG8_WAIT_L(0); PG8_BAR; PG8_MMA(0, 0, At, B0); PG8_MMA(0, 1, At, B1); PG8_BAR; PG8_SCHED;
            PG8_LDA(At, 0, 1); PG8_STAGE(PG8_SB(0, 0), b2, voffB); PG8_STAGE(PG8_SB(0, 1), b2 + hstep, voffB); PG8_STAGE(PG8_SA(0, 0), a2, voffA);
            PG8_WAIT_V(8); PG8_WAIT_L(0); PG8_BAR; PG8_MMA(1, 0, At, B0); PG8_MMA(1, 1, At, B1); PG8_BAR; PG8_SCHED;
            PG8_LDB(B0, 1, 0); PG8_LDB(B1, 1, 1); PG8_SCHED; PG8_LDA(At, 1, 0); PG8_STAGE(PG8_SA(0, 1), a2 + hstep, voffA);
            PG8_WAIT_V(8); PG8_WAIT_L(0); PG8_BAR; PG8_MMA(0, 0, At, B0); PG8_MMA(0, 1, At, B1); PG8_BAR; PG8_SCHED;
            PG8_LDA(At, 1, 1); PG8_STAGE(PG8_SB(1, 0), b3, voffB); PG8_STAGE(PG8_SB(1, 1), b3 + hstep, voffB); PG8_STAGE(PG8_SA(1, 0), a3, voffA);
            PG8_WAIT_V(8); PG8_WAIT_L(0); PG8_BAR; PG8_MMA(1, 0, At, B0); PG8_MMA(1, 1, At, B1); PG8_BAR; PG8_SCHED;
            } else {
            PG8_LDB(B0, 0, 0); PG8_SCHED; PG8_LDA(At, 0, 0); PG8_STAGE(PG8_SA(1, 1), a1 + hstep, voffA);
            PG8_WAIT_L(8); PG8_BAR; PG8_WAIT_L(0); PG8_MMA(0, 0, At, B0); PG8_BAR; PG8_SCHED;
            PG8_LDB(B1, 0, 1); PG8_STAGE(PG8_SB(0, 0), b2, voffB);
            PG8_BAR; PG8_WAIT_L(0); PG8_MMA(0, 1, At, B1); PG8_BAR;
            PG8_LDA(At, 0, 1); PG8_STAGE(PG8_SA(0, 0), a2, voffA);
            PG8_BAR; PG8_WAIT_L(0); PG8_MMA(1, 0, At, B0); PG8_BAR; PG8_SCHED;
            PG8_STAGE(PG8_SB(0, 1), b2 + hstep, voffB);
            PG8_WAIT_V(6); PG8_BAR; PG8_MMA(1, 1, At, B1); PG8_BAR;
            PG8_LDB(B0, 1, 0); PG8_SCHED; PG8_LDA(At, 1, 0); PG8_STAGE(PG8_SA(0, 1), a2 + hstep, voffA);
            PG8_WAIT_L(8); PG8_BAR; PG8_WAIT_L(0); PG8_MMA(0, 0, At, B0); PG8_BAR; PG8_SCHED;
            PG8_LDB(B1, 1, 1); PG8_STAGE(PG8_SB(1, 0), b3, voffB);
            PG8_BAR; PG8_WAIT_L(0); PG8_MMA(0, 1, At, B1); PG8_BAR;
            PG8_LDA(At, 1, 1); PG8_STAGE(PG8_SA(1, 0), a3, voffA);
            PG8_BAR; PG8_WAIT_L(0); PG8_MMA(1, 0, At, B0); PG8_BAR; PG8_SCHED;
            PG8_STAGE(PG8_SB(1, 1), b3 + hstep, voffB);
            PG8_WAIT_V(6); PG8_BAR; PG8_MMA(1, 1, At, B1); PG8_BAR;
            }
        }
        if constexpr (ALIGN_EPI) { if (wr == 0) PG8_BAR; }
        bool keep = false;
        if constexpr (Epi::MID) keep = (cur.seg == 0);
        if constexpr (!Epi::AFTER_DRAIN) { if (keep) { if constexpr (Epi::MID) E.mid(acc, cur, wr, wc, fr, fq); } else E(acc, cur, wr, wc, fr, fq); S.done(cur); }
        if (!has_next) break;
        if (!keep) {
#pragma unroll
        for (int a = 0; a < 2; ++a)
#pragma unroll
            for (int b = 0; b < 2; ++b)
#pragma unroll
                for (int m = 0; m < 4; ++m)
#pragma unroll
                    for (int n = 0; n < 2; ++n) acc[a][b][m][n] = (f32x4){0.f, 0.f, 0.f, 0.f};
        }
        cur = nxt; cA = nA; cB = nB; ++ui;
        if constexpr (ALIGN_EPI) { if (wr == 1) PG8_BAR; }
    }
    PG8_WAIT_V(0);
    if constexpr (!ALIGN_EPI) { if (wr == 0) PG8_BAR; }
    PG8_BAR;
    if constexpr (Epi::AFTER_DRAIN) { E.fused(acc, cur, wr, wc, fr, fq, lds, wid, lane); S.done(cur); }
#undef PG8_SA
#undef PG8_SB
#undef PG8_STAGE
#undef PG8_LDA
#undef PG8_LDB
#undef PG8_MMA
#undef PG8_WAIT_V
#undef PG8_WAIT_L
#undef PG8_BAR
#undef PG8_SCHED
}
}

typedef pg8::bf16_t bf16_t;
typedef pg8::f32x4 f32x4;
typedef pg8::u32x4 u32x4;
typedef unsigned u32x2 __attribute__((ext_vector_type(2)));
typedef pg8::Unit Unit;
#define LAS __attribute__((address_space(3)))

constexpr int T_ = 16384, D_ = 2048, L_ = 4096, NIN = 9216, W5 = 1024, HW = 1024, FF = 5632, NUP = 11264;
constexpr float RMS_EPS = 1e-6f;
constexpr size_t MiB = (size_t)1 << 20;
constexpr size_t WS_CTL = 0;
constexpr size_t CTL_SSQ2 = 256 * 1024, CTL_SSQ3 = 384 * 1024, CTL_CNT7 = 512 * 1024  ;
constexpr size_t WS_S5TAB = 1 * MiB;
constexpr size_t WS_RSTD1 = 12 * MiB, WS_LB = 12 * MiB + 192 * 1024, WS_EGL = 13 * MiB;
constexpr size_t WS_WGLU = 16 * MiB, WS_WPS5 = 18 * MiB, WS_WPH = 22 * MiB, WS_WOUT = 26 * MiB, WS_WDOWN = 34 * MiB, WS_WUP = 56 * MiB, WS_WIN = 100 * MiB;
constexpr size_t WS_XB2 = 136 * MiB;
#ifndef X_BF16_RESID
#define X_BF16_RESID 1
#endif
constexpr size_t WS_XB = 136 * MiB, WS_UG = 200 * MiB, WS_QD = 232 * MiB, WS_KD = 264 * MiB, WS_V = 296 * MiB, WS_G = 328 * MiB;
constexpr size_t WS_LOGF = 360 * MiB, WS_SQ = 424 * MiB, WS_KKR = 456 * MiB;
constexpr size_t WS_Z = 360 * MiB  , WS_ZS = 296 * MiB  , WS_OH = 200 * MiB, WS_ORAW = 424 * MiB, WS_ORAW_NAIVE = 232 * MiB, WS_SSQH = 488 * MiB;
constexpr size_t WS_MERGED = 232 * MiB, WS_X1B = 296 * MiB, WS_ACT = 100 * MiB, WS_RAW = 360 * MiB, WS_UPQ = 360 * MiB  ;

__device__ __forceinline__ float bf2f(unsigned short b) { return __uint_as_float(((unsigned)b) << 16); }
__device__ __forceinline__ float sigmoid_f(float x) { return __builtin_amdgcn_rcpf(1.0f + __expf(-x)); }
__device__ __forceinline__ float silu_f(float x) { return x * sigmoid_f(x); }
__device__ __forceinline__ float gelu_tanh_f(float x) { const float a = 1.5957691216057308f * (x + 0.044715f * x * x * x); return x * sigmoid_f(a); }
__device__ __forceinline__ u32x4 pack8(const float* v) { u32x4 w; w.x = pg8::cvt_pk_bf16(v[0], v[1]); w.y = pg8::cvt_pk_bf16(v[2], v[3]); w.z = pg8::cvt_pk_bf16(v[4], v[5]); w.w = pg8::cvt_pk_bf16(v[6], v[7]); return w; }
__device__ __forceinline__ void unpack8(const u32x4 w, float* v) { v[0] = __uint_as_float(w.x << 16); v[1] = __uint_as_float(w.x & 0xffff0000u); v[2] = __uint_as_float(w.y << 16); v[3] = __uint_as_float(w.y & 0xffff0000u);
    v[4] = __uint_as_float(w.z << 16); v[5] = __uint_as_float(w.z & 0xffff0000u); v[6] = __uint_as_float(w.w << 16); v[7] = __uint_as_float(w.w & 0xffff0000u); }
#define ACC8(v, a, sc) do { v[0] = a[0][0] * (sc); v[1] = a[0][1] * (sc); v[2] = a[0][2] * (sc); v[3] = a[0][3] * (sc); v[4] = a[1][0] * (sc); v[5] = a[1][1] * (sc); v[6] = a[1][2] * (sc); v[7] = a[1][3] * (sc); } while (0)

struct EpiProj {
    static constexpr bool PERM = true, AFTER_DRAIN = false, MID = false;
    const float* rstd; const float* lb; bf16_t *UG, *SQ, *KKR, *V, *G, *GS5, *GH; float* LOGF;
    __device__ __forceinline__ void operator()(const f32x4 (&acc)[2][2][4][2], const Unit& u, int wr, int wc, int fr, int fq) const {
        const int rowb = u.pm * 256 + wr * 64 + fr, cb = wc * 32 + 8 * fq, pn = u.pn;
#pragma unroll
        for (int ai = 0; ai < 2; ++ai)
#pragma unroll
            for (int m = 0; m < 4; ++m) {
                const int row = rowb + ai * 128 + m * 16; const float s = rstd[row];
#pragma unroll
                for (int bj = 0; bj < 2; ++bj) {
                    float v[8]; ACC8(v, acc[ai][bj][m], s);
                    if (pn < 4) { const int col = pn * 256 + bj * 128 + cb, g = col >> 4, c = col & 15, b = row >> 12, t = row & 4095;
                        *(u32x4*)(UG + (((size_t)(b * 64 + g) * L_ + t) * 16 + c)) = pack8(v); }
                    else if (pn < 12) { const int ch = (pn - 4) * 128 + cb;
                        if (bj == 0) { float o[8];
#pragma unroll
                            for (int j = 0; j < 8; ++j) o[j] = silu_f(v[j]);
                            *(u32x4*)(SQ + (size_t)row * HW + ch) = pack8(o); }
                        else { float lf[8], kk[8]; const f32x4 l0 = *(const f32x4*)(lb + ch), l1 = *(const f32x4*)(lb + ch + 4);
#pragma unroll
                            for (int j = 0; j < 8; ++j) { const float lbv = j < 4 ? l0[j] : l1[j - 4]; const float sg = sigmoid_f(v[j]); lf[j] = __logf(lbv + (1.0f - lbv) * sg); kk[j] = (1.0f - lbv) * sigmoid_f(-v[j]); }
                            *(f32x4*)(LOGF + (size_t)row * HW + ch) = (f32x4){lf[0], lf[1], lf[2], lf[3]}; *(f32x4*)(LOGF + (size_t)row * HW + ch + 4) = (f32x4){lf[4], lf[5], lf[6], lf[7]};
                            *(u32x4*)(KKR + (size_t)row * HW + ch) = pack8(kk); } }
                    else if (pn < 16) { const int col = (pn - 12) * 256 + bj * 128 + cb; *(u32x4*)(V + (size_t)row * HW + col) = pack8(v); }
                    else if (pn < 20) { const int col = (pn - 16) * 256 + bj * 128 + cb; float o[8];
#pragma unroll
                        for (int j = 0; j < 8; ++j) o[j] = silu_f(v[j]);
                        *(u32x4*)(G + (size_t)row * HW + col) = pack8(o); }
                    else { const int col = ((pn - 20) & 7) * 256 + bj * 128 + cb; float o[8];
#pragma unroll
                        for (int j = 0; j < 8; ++j) o[j] = sigmoid_f(v[j]);
                        *(u32x4*)((pn < 28 ? GS5 : GH) + (size_t)row * D_ + col) = pack8(o); }
                }
            }
    }
};
struct EpiGlu {
    static constexpr bool PERM = true, AFTER_DRAIN = false, MID = false;
    const bf16_t* Z; const float* bias; bf16_t* ZS;
    __device__ __forceinline__ void operator()(const f32x4 (&acc)[2][2][4][2], const Unit& u, int wr, int wc, int fr, int fq) const {
        const int rowb = u.pm * 256 + wr * 64 + fr, colb = u.pn * 256 + wc * 32 + 8 * fq;
#pragma unroll
        for (int ai = 0; ai < 2; ++ai)
#pragma unroll
            for (int m = 0; m < 4; ++m) { const int row = rowb + ai * 128 + m * 16;
#pragma unroll
                for (int bj = 0; bj < 2; ++bj) { const int col = colb + bj * 128; float v[8], z[8], o[8]; ACC8(v, acc[ai][bj][m], 1.0f);
                    unpack8(*(const u32x4*)(Z + (size_t)row * W5 + col), z); const f32x4 b0 = *(const f32x4*)(bias + col), b1 = *(const f32x4*)(bias + col + 4);
#pragma unroll
                    for (int j = 0; j < 8; ++j) o[j] = z[j] * sigmoid_f(v[j] + (j < 4 ? b0[j] : b1[j - 4]));
                    *(u32x4*)(ZS + (size_t)row * W5 + col) = pack8(o); } }
    }
};
struct EpiMerged {
    static constexpr bool PERM = true, AFTER_DRAIN = false, MID = true;
    const bf16_t* GS5; const bf16_t* GH; bf16_t* MERGED;
    __device__ __forceinline__ void mid(f32x4 (&acc)[2][2][4][2], const Unit& u, int wr, int wc, int fr, int fq) const {
        const int rowb = u.pm * 256 + wr * 64 + fr, colb = u.pn * 256 + wc * 32 + 8 * fq;
#pragma unroll
        for (int ai = 0; ai < 2; ++ai)
#pragma unroll
            for (int m = 0; m < 4; ++m) { const int row = rowb + ai * 128 + m * 16;
#pragma unroll
                for (int bj = 0; bj < 2; ++bj) { const size_t o = (size_t)row * D_ + colb + bj * 128; float a[8]; unpack8(*(const u32x4*)(GS5 + o), a);
#pragma unroll
                    for (int j = 0; j < 8; ++j) acc[ai][bj][m][j >> 2][j & 3] *= a[j]; }
                asm volatile("" ::: "memory"); }
    }
    __device__ __forceinline__ void operator()(const f32x4 (&acc)[2][2][4][2], const Unit& u, int wr, int wc, int fr, int fq) const {
        const int rowb = u.pm * 256 + wr * 64 + fr, colb = u.pn * 256 + wc * 32 + 8 * fq;
#pragma unroll
        for (int ai = 0; ai < 2; ++ai)
#pragma unroll
            for (int m = 0; m < 4; ++m) { const int row = rowb + ai * 128 + m * 16;
#pragma unroll
                for (int bj = 0; bj < 2; ++bj) { const size_t o = (size_t)row * D_ + colb + bj * 128; float v[8], b[8]; ACC8(v, acc[ai][bj][m], 1.0f); unpack8(*(const u32x4*)(GH + o), b);
#pragma unroll
                    for (int j = 0; j < 8; ++j) v[j] *= b[j];
                    *(u32x4*)(MERGED + o) = pack8(v); }
                asm volatile("" ::: "memory"); }
    }
};
struct EpiRes {
    static constexpr bool PERM = true, AFTER_DRAIN = false, MID = false;
    const float* XI; float* XO; bf16_t* XBF; float* ssq; const bf16_t* XIB;
    __device__ __forceinline__ void operator()(const f32x4 (&acc)[2][2][4][2], const Unit& u, int wr, int wc, int fr, int fq) const {
        const int rowb = u.pm * 256 + wr * 64 + fr, colb = u.pn * 256 + wc * 32 + 8 * fq;
#pragma unroll
        for (int ai = 0; ai < 2; ++ai)
#pragma unroll
            for (int m = 0; m < 4; ++m) { const int row = rowb + ai * 128 + m * 16; float sq = 0.f;
#pragma unroll
                for (int bj = 0; bj < 2; ++bj) { const size_t o = (size_t)row * D_ + colb + bj * 128; f32x4 x0, x1;
                    if (XIB) { float xv[8]; unpack8(*(const u32x4*)(XIB + o), xv); x0 = (f32x4){xv[0], xv[1], xv[2], xv[3]}; x1 = (f32x4){xv[4], xv[5], xv[6], xv[7]}; } else { x0 = *(const f32x4*)(XI + o); x1 = *(const f32x4*)(XI + o + 4); }
                    const f32x4 y0 = x0 + acc[ai][bj][m][0], y1 = x1 + acc[ai][bj][m][1];
                    if (XO) { *(f32x4*)(XO + o) = y0; *(f32x4*)(XO + o + 4) = y1; }
                    sq += (y0[0] * y0[0] + y0[1] * y0[1]) + (y0[2] * y0[2] + y0[3] * y0[3]) + (y1[0] * y1[0] + y1[1] * y1[1]) + (y1[2] * y1[2] + y1[3] * y1[3]);
                    if (XBF) { float v[8] = {y0[0], y0[1], y0[2], y0[3], y1[0], y1[1], y1[2], y1[3]}; *(u32x4*)(XBF + o) = pack8(v); } }
                sq += __shfl_xor(sq, 16); sq += __shfl_xor(sq, 32);
                if (fq == 0) atomicAdd(ssq + row, sq); }
    }
};
struct EpiResFinal {
    static constexpr bool PERM = true, AFTER_DRAIN = false, MID = false;
    float* XO; const bf16_t* X1; float* ssq; unsigned* cnt; const float* gfin; unsigned* tmo;
    __device__ __forceinline__ void operator()(const f32x4 (&acc)[2][2][4][2], const Unit& u, int wr, int wc, int fr, int fq) const {
        const int rowb = u.pm * 256 + wr * 64 + fr, colb = u.pn * 256 + wc * 32 + 8 * fq; float sink = 0.f;
#pragma unroll
        for (int ai = 0; ai < 2; ++ai)
#pragma unroll
            for (int m = 0; m < 4; ++m) { const int row = rowb + ai * 128 + m * 16; float sq = 0.f;
#pragma unroll
                for (int bj = 0; bj < 2; ++bj) { const size_t o = (size_t)row * D_ + colb + bj * 128; float xv[8]; unpack8(*(const u32x4*)(X1 + o), xv);
                    const f32x4 y0 = (f32x4){xv[0], xv[1], xv[2], xv[3]} + acc[ai][bj][m][0], y1 = (f32x4){xv[4], xv[5], xv[6], xv[7]} + acc[ai][bj][m][1];
                    sq += (y0[0] * y0[0] + y0[1] * y0[1]) + (y0[2] * y0[2] + y0[3] * y0[3]) + (y1[0] * y1[0] + y1[1] * y1[1]) + (y1[2] * y1[2] + y1[3] * y1[3]); }
                sq += __shfl_xor(sq, 16); sq += __shfl_xor(sq, 32);
                if (fq == 0) sink += __hip_atomic_fetch_add(ssq + row, sq, __ATOMIC_RELAXED, __HIP_MEMORY_SCOPE_AGENT); }
        asm volatile("s_waitcnt vmcnt(0)" :: "v"(sink) : "memory");
        unsigned* c = cnt + 64 * u.pm;
        if (fq * 16 + fr == 0) __hip_atomic_fetch_add(c, 1u, __ATOMIC_RELAXED, __HIP_MEMORY_SCOPE_AGENT);
        { unsigned sp = 0; while ((unsigned)__builtin_amdgcn_readfirstlane(__hip_atomic_load(c, __ATOMIC_RELAXED, __HIP_MEMORY_SCOPE_AGENT)) < 64u) { __builtin_amdgcn_s_sleep(2);
              if (++sp > (1u << 22)) { if (fq * 16 + fr == 0) __hip_atomic_store(tmo, 1u, __ATOMIC_RELAXED, __HIP_MEMORY_SCOPE_AGENT); break; } } }
#pragma unroll
        for (int ai = 0; ai < 2; ++ai)
#pragma unroll
            for (int m = 0; m < 4; ++m) { const int row = rowb + ai * 128 + m * 16; const float r = rsqrtf(__hip_atomic_load(ssq + row, __ATOMIC_RELAXED, __HIP_MEMORY_SCOPE_AGENT) * (1.0f / D_) + RMS_EPS);
#pragma unroll
                for (int bj = 0; bj < 2; ++bj) { const size_t o = (size_t)row * D_ + colb + bj * 128; const f32x4 g0 = *(const f32x4*)(gfin + colb + bj * 128), g1 = *(const f32x4*)(gfin + colb + bj * 128 + 4);
                    float xv[8]; unpack8(*(const u32x4*)(X1 + o), xv); const f32x4 y0 = (f32x4){xv[0], xv[1], xv[2], xv[3]} + acc[ai][bj][m][0], y1 = (f32x4){xv[4], xv[5], xv[6], xv[7]} + acc[ai][bj][m][1];
                    *(f32x4*)(XO + o) = y0 * r * g0; *(f32x4*)(XO + o + 4) = y1 * r * g1; }
                asm volatile("" ::: "memory"); }
    }
};
struct EpiUpNaive {
    static constexpr bool PERM = true, AFTER_DRAIN = false, MID = false;
    const float* ssq; bf16_t* UP; int row0, pad;
    __device__ __forceinline__ void operator()(const f32x4 (&acc)[2][2][4][2], const Unit& u, int wr, int wc, int fr, int fq) const {
        const int rowb = u.pm * 256 + wr * 64 + fr, colb = u.pn * 256 + wc * 32 + 8 * fq;
#pragma unroll
        for (int ai = 0; ai < 2; ++ai)
#pragma unroll
            for (int m = 0; m < 4; ++m) { const int row = rowb + ai * 128 + m * 16; const float s = rsqrtf(ssq[row0 + row] * (1.0f / D_) + RMS_EPS);
#pragma unroll
                for (int bj = 0; bj < 2; ++bj) { float v[8]; ACC8(v, acc[ai][bj][m], s); *(u32x4*)(UP + (size_t)row * NUP + colb + bj * 128) = pack8(v); } }
    }
};


__device__ __forceinline__ float dpp_shr0(float x, int) { return x; }
#define DPP_SHR_Z(x, n) __builtin_bit_cast(float, __builtin_amdgcn_update_dpp(0, __builtin_bit_cast(int, (x)), 0x110 + (n), 0xf, 0xf, true))
#define DPP_SHR_OLD(old, x, n) __builtin_bit_cast(float, __builtin_amdgcn_update_dpp(__builtin_bit_cast(int, (old)), __builtin_bit_cast(int, (x)), 0x110 + (n), 0xf, 0xf, false))
#define DPP_ROR(x, n) __builtin_bit_cast(float, __builtin_amdgcn_mov_dpp(__builtin_bit_cast(int, (x)), 0x120 + (n), 0xf, 0xf, false))

struct EpiProjF {
    static constexpr bool PERM = true, AFTER_DRAIN = false, MID = false;
    const float* rstd; const float* lb; bf16_t *UG, *QD, *KD, *V, *G, *GS5, *GH; float* EGL;
    __device__ __forceinline__ void operator()(const f32x4 (&acc)[2][2][4][2], const Unit& u, int wr, int wc, int fr, int fq) const {
        const int rowb = u.pm * 256 + wr * 64 + fr, cb = wc * 32 + 8 * fq, pn = u.pn;
        if (pn >= 20) {
            const int col = (pn - 20) * 128 + cb;
#pragma unroll
            for (int ai = 0; ai < 2; ++ai)
#pragma unroll
                for (int m = 0; m < 4; ++m) { const int row = rowb + ai * 128 + m * 16; const float s = rstd[row]; float a0[8], a1[8], r[8], g[8]; ACC8(a0, acc[ai][0][m], s); ACC8(a1, acc[ai][1][m], s);
#pragma unroll
                    for (int j = 0; j < 8; ++j) { const float p0 = 1.0f + __expf(-a0[j]), p1 = 1.0f + __expf(-a1[j]), t = __builtin_amdgcn_rcpf(p0 * p1); g[j] = t * p0; r[j] = p1 * p1 * t; }
                    *(u32x4*)(GS5 + (size_t)row * D_ + col) = pack8(r); *(u32x4*)(GH + (size_t)row * D_ + col) = pack8(g); }
            return;
        }
        if (pn >= 4 && pn < 12) {
            const int ch = (pn - 4) * 128 + cb; const int lane = fq * 16 + fr;
#pragma unroll
            for (int ai = 0; ai < 2; ++ai)
#pragma unroll
                for (int n = 0; n < 2; ++n) {
                    const f32x4 l0 = *(const f32x4*)(lb + ch + 4 * n);
                    float bsum[4][4], kk[4][4];
#pragma unroll
                    for (int m = 0; m < 4; ++m) { const float s = rstd[rowb + ai * 128 + m * 16]; const f32x4 z = acc[ai][1][m][n] * s;
#pragma unroll
                        for (int j = 0; j < 4; ++j) { const float lbv = l0[j]; const float em = __expf(-fmaxf(z[j], -80.0f)), sg = __builtin_amdgcn_rcpf(1.0f + em); float x = __logf(lbv + (1.0f - lbv) * sg); kk[m][j] = (1.0f - lbv) * (em * sg);
                            x += DPP_SHR_Z(x, 1); x += DPP_SHR_Z(x, 2); x += DPP_SHR_Z(x, 4); x += DPP_SHR_Z(x, 8); bsum[m][j] = x; } }
#pragma unroll
                    for (int j = 0; j < 4; ++j) { float carry = 0.f;
#pragma unroll
                        for (int m = 0; m < 4; ++m) { const float tot = __shfl(bsum[m][j], (lane & 48) | 15); bsum[m][j] += carry; carry += tot; } }
#pragma unroll
                    for (int m = 0; m < 4; ++m) { const int row = rowb + ai * 128 + m * 16; const float s = rstd[row]; const f32x4 q = acc[ai][0][m][n] * s; float oq[4], ok[4];
#pragma unroll
                        for (int j = 0; j < 4; ++j) { oq[j] = silu_f(q[j]) * __expf(bsum[m][j]); ok[j] = kk[m][j] * __expf(-bsum[m][j]); }
                        u32x2 wq, wk; wq.x = pg8::cvt_pk_bf16(oq[0], oq[1]); wq.y = pg8::cvt_pk_bf16(oq[2], oq[3]); wk.x = pg8::cvt_pk_bf16(ok[0], ok[1]); wk.y = pg8::cvt_pk_bf16(ok[2], ok[3]);
                        *(u32x2*)(QD + (size_t)row * HW + ch + 4 * n) = wq; *(u32x2*)(KD + (size_t)row * HW + ch + 4 * n) = wk; }
                    if (fr == 15) { const int chunk = (u.pm * 256 + ai * 128 + wr * 64) >> 6;
                        *(f32x4*)(EGL + (size_t)chunk * HW + ch + 4 * n) = (f32x4){__expf(bsum[3][0]), __expf(bsum[3][1]), __expf(bsum[3][2]), __expf(bsum[3][3])}; }
                    asm volatile("" ::: "memory");
                }
            return;
        }
#pragma unroll
        for (int ai = 0; ai < 2; ++ai)
#pragma unroll
            for (int m = 0; m < 4; ++m) {
                const int row = rowb + ai * 128 + m * 16; const float s = rstd[row];
#pragma unroll
                for (int bj = 0; bj < 2; ++bj) {
                    float v[8]; ACC8(v, acc[ai][bj][m], s);
                    if (pn < 4) { const int col = pn * 256 + bj * 128 + cb, g = col >> 4, c = col & 15, b = row >> 12, t = row & 4095;
                        *(u32x4*)(UG + (((size_t)(b * 64 + g) * L_ + t) * 16 + c)) = pack8(v); }
                    else if (pn < 16) { const int col = (pn - 12) * 256 + bj * 128 + cb; *(u32x4*)(V + (size_t)row * HW + col) = pack8(v); }
                    else if (pn < 20) { const int col = (pn - 16) * 256 + bj * 128 + cb; float o[8];
#pragma unroll
                        for (int j = 0; j < 8; ++j) o[j] = silu_f(v[j]);
                        *(u32x4*)(G + (size_t)row * HW + col) = pack8(o); }
                    else { const int col = ((pn - 20) & 7) * 256 + bj * 128 + cb; float o[8];
#pragma unroll
                        for (int j = 0; j < 8; ++j) o[j] = sigmoid_f(v[j]);
                        *(u32x4*)((pn < 28 ? GS5 : GH) + (size_t)row * D_ + col) = pack8(o); }
                }
            }
    }
};

struct EpiUpConv {
    static constexpr bool PERM = true, AFTER_DRAIN = false, MID = false;
    const float* ssq; const float* cw; const float* cb; bf16_t* ACT; bf16_t* RAW;
    __device__ __forceinline__ void operator()(const f32x4 (&acc)[2][2][4][2], const Unit& u, int wr, int wc, int fr, int fq) const {
        const int rowb = u.pm * 256 + wr * 64 + fr, j0 = u.pn * 128 + wc * 32 + 8 * fq;
        float rs[2][4];
#pragma unroll
        for (int ai = 0; ai < 2; ++ai)
#pragma unroll
            for (int m = 0; m < 4; ++m) rs[ai][m] = rsqrtf(ssq[rowb + ai * 128 + m * 16] * (1.0f / D_) + RMS_EPS);
        f32x4 wv[2][8];
#pragma unroll
        for (int n = 0; n < 2; ++n) { const int j = j0 + 4 * n; wv[n][0] = *(const f32x4*)(cw + j); wv[n][1] = *(const f32x4*)(cw + NUP + j); wv[n][2] = *(const f32x4*)(cw + 2 * NUP + j); wv[n][3] = *(const f32x4*)(cb + j);
            wv[n][4] = *(const f32x4*)(cw + FF + j); wv[n][5] = *(const f32x4*)(cw + NUP + FF + j); wv[n][6] = *(const f32x4*)(cw + 2 * NUP + FF + j); wv[n][7] = *(const f32x4*)(cb + FF + j); }
#pragma unroll
        for (int n = 0; n < 2; ++n) { const int j = j0 + 4 * n;
            const f32x4 g0 = wv[n][0], g1 = wv[n][1], g2 = wv[n][2], gb = wv[n][3], v0 = wv[n][4], v1 = wv[n][5], v2 = wv[n][6], vb = wv[n][7];
#pragma unroll
            for (int ai = 0; ai < 2; ++ai) { const int blk = (u.pm * 256 + ai * 128 + wr * 64) >> 6; f32x4 pg = (f32x4){0.f, 0.f, 0.f, 0.f}, pv = pg;
#pragma unroll
                for (int m = 0; m < 4; ++m) { const int row = rowb + ai * 128 + m * 16; f32x4 ug = acc[ai][0][m][n] * rs[ai][m], uv = acc[ai][1][m][n] * rs[ai][m]; f32x4 cg, cv;
#pragma unroll
                    for (int e = 0; e < 4; ++e) { float ugs = ug[e], uvs = uv[e], pgs = pg[e], pvs = pv[e]; asm volatile("" : "+v"(ugs), "+v"(uvs), "+v"(pgs), "+v"(pvs));
                        float g1s, g2s, v1s, v2s;
                        if (m == 0) { g1s = DPP_SHR_Z(ugs, 1); g2s = DPP_SHR_Z(ugs, 2); v1s = DPP_SHR_Z(uvs, 1); v2s = DPP_SHR_Z(uvs, 2); }
                        else { g1s = DPP_SHR_OLD(DPP_ROR(pgs, 1), ugs, 1); g2s = DPP_SHR_OLD(DPP_ROR(pgs, 2), ugs, 2); v1s = DPP_SHR_OLD(DPP_ROR(pvs, 1), uvs, 1); v2s = DPP_SHR_OLD(DPP_ROR(pvs, 2), uvs, 2); }
                        asm volatile("" : "+v"(g1s), "+v"(g2s), "+v"(v1s), "+v"(v2s));
                        cg[e] = gb[e] + g0[e] * g2s + g1[e] * g1s + g2[e] * ugs; cv[e] = vb[e] + v0[e] * v2s + v1[e] * v1s + v2[e] * uvs; ug[e] = ugs; uv[e] = uvs; }
                    if (m > 0 || fr >= 2) { u32x2 o; o.x = pg8::cvt_pk_bf16(silu_f(cg[0]) * cv[0], silu_f(cg[1]) * cv[1]); o.y = pg8::cvt_pk_bf16(silu_f(cg[2]) * cv[2], silu_f(cg[3]) * cv[3]); *(u32x2*)(ACT + (size_t)row * FF + j) = o; }
                    if ((m == 0 && fr < 2) || (m == 3 && fr >= 14)) { bf16_t* r = RAW + ((size_t)blk * 4 + (m == 0 ? 2 + fr : fr - 14)) * NUP; u32x2 a2, b2; a2.x = pg8::cvt_pk_bf16(ug[0], ug[1]); a2.y = pg8::cvt_pk_bf16(ug[2], ug[3]); b2.x = pg8::cvt_pk_bf16(uv[0], uv[1]); b2.y = pg8::cvt_pk_bf16(uv[2], uv[3]);
                        *(u32x2*)(r + j) = a2; *(u32x2*)(r + FF + j) = b2; }
                    pg = ug; pv = uv; } } }
    }
};
__device__ __forceinline__ f32x4 ld4bf(const bf16_t* p) { const u32x2 w = *(const u32x2*)p; return (f32x4){__uint_as_float(w.x << 16), __uint_as_float(w.x & 0xffff0000u), __uint_as_float(w.y << 16), __uint_as_float(w.y & 0xffff0000u)}; }
__device__ __forceinline__ void conv_fixup(const bf16_t* RAW, const float* cw, const float* cb, bf16_t* ACT, int blk0, int nblk, int tid0, int nthreads) {
#pragma unroll 4
    for (int it = tid0; it < nblk * (FF / 4); it += nthreads) { const int blk = blk0 + it / (FF / 4), j = (it % (FF / 4)) * 4; const bool first = (blk & 63) == 0;
        const bf16_t* rp = RAW + (size_t)(blk - 1) * 4 * NUP; const bf16_t* rc = RAW + (size_t)blk * 4 * NUP; const f32x4 z4 = (f32x4){0.f, 0.f, 0.f, 0.f};
        f32x4 g[4], v[4];
        g[0] = first ? z4 : ld4bf(rp + j); g[1] = first ? z4 : ld4bf(rp + NUP + j); g[2] = ld4bf(rc + 2 * NUP + j); g[3] = ld4bf(rc + 3 * NUP + j);
        v[0] = first ? z4 : ld4bf(rp + FF + j); v[1] = first ? z4 : ld4bf(rp + NUP + FF + j); v[2] = ld4bf(rc + 2 * NUP + FF + j); v[3] = ld4bf(rc + 3 * NUP + FF + j);
        const f32x4 g0 = *(const f32x4*)(cw + j), g1 = *(const f32x4*)(cw + NUP + j), g2 = *(const f32x4*)(cw + 2 * NUP + j), gb = *(const f32x4*)(cb + j);
        const f32x4 v0 = *(const f32x4*)(cw + FF + j), v1 = *(const f32x4*)(cw + NUP + FF + j), v2 = *(const f32x4*)(cw + 2 * NUP + FF + j), vb = *(const f32x4*)(cb + FF + j);
#pragma unroll
        for (int pos = 0; pos < 2; ++pos) { const f32x4 cg = gb + g0 * g[pos] + g1 * g[pos + 1] + g2 * g[pos + 2], cv = vb + v0 * v[pos] + v1 * v[pos + 1] + v2 * v[pos + 2];
            u32x2 o; o.x = pg8::cvt_pk_bf16(silu_f(cg[0]) * cv[0], silu_f(cg[1]) * cv[1]); o.y = pg8::cvt_pk_bf16(silu_f(cg[2]) * cv[2], silu_f(cg[3]) * cv[3]); *(u32x2*)(ACT + ((size_t)blk * 64 + pos) * FF + j) = o; } }
}
__global__ void __launch_bounds__(512, 2) k_conv_fixup(const bf16_t* RAW, const float* cw, const float* cb, bf16_t* ACT) { conv_fixup(RAW, cw, cb, ACT, 0, 256, blockIdx.x * 512 + threadIdx.x, gridDim.x * 512); }

__global__ void __launch_bounds__(512, 2) k_gemm_pair(pg8::Gemm g, EpiMerged E) {
    extern __shared__ __attribute__((aligned(16))) unsigned char lds[];
    pg8::PairOrder S; S.init(g.M, g.N, (int)gridDim.x, (int)blockIdx.x);
    pg8::gemm_phase<EpiMerged, pg8::PairOrder, true, true>((LAS unsigned char*)lds, g, S, E);
}
struct EpiNull {
    static constexpr bool PERM = true, AFTER_DRAIN = false, MID = false;
    float* sink;
    __device__ __forceinline__ void operator()(const f32x4 (&acc)[2][2][4][2], const Unit& u, int wr, int wc, int fr, int fq) const {
        f32x4 s = (f32x4){0.f, 0.f, 0.f, 0.f};
#pragma unroll
        for (int ai = 0; ai < 2; ++ai)
#pragma unroll
            for (int bj = 0; bj < 2; ++bj)
#pragma unroll
                for (int m = 0; m < 4; ++m) { s += acc[ai][bj][m][0]; s += acc[ai][bj][m][1]; }
        sink[(size_t)blockIdx.x * 512 + threadIdx.x] = (s[0] + s[1]) + (s[2] + s[3]) + (float)(u.pm + u.pn + wr + wc + fr + fq);
    }
};
struct EpiStoreOnly {
    static constexpr bool PERM = true, AFTER_DRAIN = false, MID = false;
    bf16_t* dst; int nslot, pad;
    __device__ __forceinline__ void operator()(const f32x4 (&acc)[2][2][4][2], const Unit& u, int wr, int wc, int fr, int fq) const {
        const int slot = (u.pm * 36 + u.pn) & 511; bf16_t* base = dst + (size_t)slot * 65536;
#pragma unroll
        for (int ai = 0; ai < 2; ++ai)
#pragma unroll
            for (int m = 0; m < 4; ++m)
#pragma unroll
                for (int bj = 0; bj < 2; ++bj) { float v[8]; ACC8(v, acc[ai][bj][m], 1.0f); *(u32x4*)(base + (size_t)(ai * 128 + wr * 64 + m * 16 + fr) * 256 + bj * 128 + wc * 32 + 8 * fq) = pack8(v); }
    }
};
struct EpiStoreHalf {
    static constexpr bool PERM = true, AFTER_DRAIN = false, MID = false;
    bf16_t* dst; int nslot, pad;
    __device__ __forceinline__ void operator()(const f32x4 (&acc)[2][2][4][2], const Unit& u, int wr, int wc, int fr, int fq) const {
        const int slot = (u.pm * 36 + u.pn) & 511; bf16_t* base = dst + (size_t)slot * 65536;
#pragma unroll
        for (int ai = 0; ai < 2; ++ai)
#pragma unroll
            for (int m = 0; m < 4; ++m) { float v[8], v2[8]; ACC8(v, acc[ai][0][m], 1.0f); ACC8(v2, acc[ai][1][m], 1.0f);
#pragma unroll
                for (int j = 0; j < 8; ++j) v[j] += v2[j];
                *(u32x4*)(base + (size_t)(ai * 128 + wr * 64 + m * 16 + fr) * 256 + wc * 32 + 8 * fq) = pack8(v); }
    }
};
struct EpiStoreFull {
    static constexpr bool PERM = true, AFTER_DRAIN = false, MID = false;
    bf16_t* dst; int nslot, pad;
    __device__ __forceinline__ void operator()(const f32x4 (&acc)[2][2][4][2], const Unit& u, int wr, int wc, int fr, int fq) const {
        const int slot = (u.pm * 36 + u.pn) & 511; bf16_t* base = dst + (size_t)slot * 65536; const int lane = fq * 16 + fr, w = wr * 4 + wc;
#pragma unroll
        for (int ai = 0; ai < 2; ++ai)
#pragma unroll
            for (int m = 0; m < 4; ++m)
#pragma unroll
                for (int bj = 0; bj < 2; ++bj) { float v[8]; ACC8(v, acc[ai][bj][m], 1.0f); const int k = (ai * 4 + m) * 2 + bj;
                    *(u32x4*)(base + (size_t)w * 8192 + (size_t)(8 * k + (lane >> 3)) * 64 + (lane & 7) * 8) = pack8(v); }
    }
};
template <class Epi> __global__ void __launch_bounds__(512, 2) k_gemm(pg8::Gemm g, Epi E) {
    extern __shared__ __attribute__((aligned(16))) unsigned char lds[];
    pg8::StaticOrder S; S.init(g.M, g.N, (int)gridDim.x, (int)blockIdx.x);
    pg8::gemm_phase<Epi, pg8::StaticOrder, true, true>((LAS unsigned char*)lds, g, S, E);
}

__device__ __forceinline__ int dest_row(int mode, int n) {
    if (mode == 1) { if (n >= 1024 && n < 2048) { const int i = n - 1024; return 1024 + 256 * (i >> 7) + (i & 127); } if (n >= 2048 && n < 3072) { const int i = n - 2048; return 1024 + 256 * (i >> 7) + 128 + (i & 127); }
        if (n >= 5120 && n < 7168) { const int i = n - 5120; return 5120 + 256 * (i >> 7) + (i & 127); } if (n >= 7168) { const int i = n - 7168; return 5120 + 256 * (i >> 7) + 128 + (i & 127); }
        return n; }
    if (mode == 2) { if (n < FF) return 256 * (n >> 7) + (n & 127); const int i = n - FF; return 256 * (i >> 7) + 128 + (i & 127); }
    return n;
}
__device__ __forceinline__ void transpose_item(const float* W, const float* gain, int K, int N, bf16_t* WT, int mode, LAS float* scr, int item, int lane) {
    const int nblk = N / 64, kb = item / nblk, nb = item % nblk, k0 = 64 * kb, n0 = 64 * nb;
    float v[64];
#pragma unroll
    for (int i = 0; i < 64; ++i) v[i] = __builtin_nontemporal_load(W + (size_t)(k0 + i) * N + n0 + lane);
    if (gain) {
#pragma unroll
        for (int i = 0; i < 64; ++i) v[i] *= gain[k0 + i]; }
#pragma unroll
    for (int i = 0; i < 64; ++i) scr[i * 65 + lane] = v[i];
    asm volatile("s_waitcnt lgkmcnt(0)" ::: "memory");
    const int c = lane & 7; const int r0 = dest_row(mode, n0);
#pragma unroll
    for (int j = 0; j < 8; ++j) { const int n = (lane >> 3) + 8 * j; const LAS float* s = scr + (8 * c) * 65 + n;
        u32x4 o; o.x = pg8::cvt_pk_bf16(s[0 * 65], s[1 * 65]); o.y = pg8::cvt_pk_bf16(s[2 * 65], s[3 * 65]); o.z = pg8::cvt_pk_bf16(s[4 * 65], s[5 * 65]); o.w = pg8::cvt_pk_bf16(s[6 * 65], s[7 * 65]);
        *(u32x4*)(WT + (size_t)(r0 + n) * K + k0 + 8 * c) = o; }
    asm volatile("s_waitcnt lgkmcnt(0)" ::: "memory");
}
#ifndef P2_PREP_FIRST
#define P2_PREP_FIRST 1
#endif
#ifndef P2_UP
#define P2_UP 5632
#endif
#ifndef PREP_RN
#define PREP_RN 13312
#endif
#ifndef PREP_NA
#define PREP_NA 6912
#endif
struct PrepArgs { const float *x, *ln_mix_g, *w_in, *w_glu, *w_ps5, *w_ph, *w_out, *ln_ffn_g, *w_up, *w_down, *lb_logits; unsigned char* ws; };
__device__ __forceinline__ void prep_phase(const PrepArgs& a, LAS unsigned char* lds, int gw, int ngw, int lane, int ntabw = 0) {
    LAS float* scr = (LAS float*)(lds + (threadIdx.x >> 6) * 16640);
    unsigned char* ws = a.ws;
    constexpr int I_IN = (D_ / 64) * (NIN / 64), I_GLU = (W5 / 64) * (W5 / 64), I_PS = (W5 / 64) * (D_ / 64), I_OUT = (D_ / 64) * (D_ / 64), I_UP = (D_ / 64) * (NUP / 64), I_DN = (FF / 64) * (D_ / 64);
    constexpr int NITEMS = I_IN + I_GLU + 2 * I_PS + I_OUT + I_UP + I_DN;
    const bool tabw = gw >= ngw - ntabw;
    constexpr int NITEMS_M = NITEMS - I_DN - P2_UP;
    const int i0 = ntabw ? (tabw ? PREP_NA + (gw - (ngw - ntabw)) : gw) : gw, i1 = ntabw ? (tabw ? NITEMS_M : PREP_NA) : NITEMS, ist = ntabw ? (tabw ? ntabw : ngw - ntabw) : ngw;
    for (int it = i0; it < i1; it += ist) {
        int r = it;
        if (ntabw) {
            if (r < I_UP - P2_UP) { transpose_item(a.w_up, a.ln_ffn_g, D_, NUP, (bf16_t*)(ws + WS_WUP), 2, scr, r + P2_UP, lane); continue; } r -= I_UP - P2_UP;
            if (r < I_IN) { transpose_item(a.w_in, a.ln_mix_g, D_, NIN, (bf16_t*)(ws + WS_WIN), 1, scr, r, lane); continue; } r -= I_IN;
        } else {
        if (r < I_UP) { transpose_item(a.w_up, a.ln_ffn_g, D_, NUP, (bf16_t*)(ws + WS_WUP), 2, scr, r, lane); continue; } r -= I_UP;
        if (r < I_IN) { transpose_item(a.w_in, a.ln_mix_g, D_, NIN, (bf16_t*)(ws + WS_WIN), 1, scr, r, lane); continue; } r -= I_IN;
        if (r < I_DN) { transpose_item(a.w_down, nullptr, FF, D_, (bf16_t*)(ws + WS_WDOWN), 0, scr, r, lane); continue; } r -= I_DN; }
        if (r < I_OUT) { transpose_item(a.w_out, nullptr, D_, D_, (bf16_t*)(ws + WS_WOUT), 0, scr, r, lane); continue; } r -= I_OUT;
        if (r < I_PS) { transpose_item(a.w_ps5, nullptr, W5, D_, (bf16_t*)(ws + WS_WPS5), 0, scr, r, lane); continue; } r -= I_PS;
        if (r < I_PS) { transpose_item(a.w_ph, nullptr, HW, D_, (bf16_t*)(ws + WS_WPH), 0, scr, r, lane); continue; } r -= I_PS;
        transpose_item(a.w_glu, nullptr, W5, W5, (bf16_t*)(ws + WS_WGLU), 0, scr, r, lane);
    }
    bf16_t* XB = (bf16_t*)(ws + WS_XB); float* rstd1 = (float*)(ws + WS_RSTD1);
    const int r0_ = ntabw ? (tabw ? PREP_RN + (gw - (ngw - ntabw)) : gw) : gw, r1_ = ntabw ? (tabw ? T_ : PREP_RN) : T_;
    for (int row = r0_; row < r1_; row += ist) {
        const f32x4* xr = (const f32x4*)(a.x + (size_t)row * D_) + lane; float s = 0.f;
#pragma unroll
        for (int j = 0; j < 8; ++j) { const f32x4 v = __builtin_nontemporal_load(xr + 64 * j); s += (v[0] * v[0] + v[1] * v[1]) + (v[2] * v[2] + v[3] * v[3]);
            uint2 o; o.x = pg8::cvt_pk_bf16(v[0], v[1]); o.y = pg8::cvt_pk_bf16(v[2], v[3]); *((uint2*)(XB + (size_t)row * D_) + lane + 64 * j) = o; }
#pragma unroll
        for (int o = 1; o < 64; o <<= 1) s += __shfl_xor(s, o);
        if (lane == 0) rstd1[row] = rsqrtf(s * (1.0f / D_) + RMS_EPS);
    }
    float* LB = (float*)(ws + WS_LB);
    for (int c = gw * 64 + lane; c < HW; c += ngw * 64) { const float l0 = a.lb_logits[c], l1 = a.lb_logits[HW + c]; LB[c] = 1.0f / (1.0f + __expf(l1 - l0)); }
}
__global__ void __launch_bounds__(512, 2) k_prep(PrepArgs a) {
    extern __shared__ __attribute__((aligned(16))) unsigned char lds[];
    prep_phase(a, (LAS unsigned char*)lds, (int)blockIdx.x * 8 + (int)(threadIdx.x >> 6), (int)gridDim.x * 8, (int)(threadIdx.x & 63));
}

__global__ void k_cumsum(const bf16_t* SQ, const float* LOGF, const bf16_t* KKR, bf16_t* QD, bf16_t* KD, float* EGL) {
    const int col = blockIdx.x * blockDim.x + threadIdx.x, chunk = blockIdx.y; float b = 0.f;
    for (int s = 0; s < 64; ++s) { const size_t o = (size_t)(chunk * 64 + s) * HW + col; b += LOGF[o];
        QD[o] = (bf16_t)(pg8::cvt_pk_bf16(bf2f(SQ[o]) * __expf(b), 0.f) & 0xffff); KD[o] = (bf16_t)(pg8::cvt_pk_bf16(bf2f(KKR[o]) * __expf(-b), 0.f) & 0xffff); }
    EGL[(size_t)chunk * HW + col] = __expf(b);
}
struct S5Args { const bf16_t* UG; const float *a_re, *a_im, *log_dt, *b_re, *b_im, *c_re, *c_im, *d; bf16_t* Z; };
__device__ __forceinline__ void sincos_rev(float x, float& s, float& c) { float r = x * 0.15915494309189535f; r -= rintf(r); s = __builtin_amdgcn_sinf(r); c = __builtin_amdgcn_cosf(r); }
__global__ void __launch_bounds__(64) k_s5_naive(S5Args a) {
    const int b = blockIdx.x >> 6, g = blockIdx.x & 63, p = threadIdx.x;
    __shared__ float H[16][128]; __shared__ float CC[16][128]; __shared__ float Us[16][16];
    const float lr = fminf(a.a_re[g * 64 + p], -1e-4f), li = a.a_im[g * 64 + p], dt = __expf(a.log_dt[g]);
    float sn, cs; sincos_rev(li * dt, sn, cs); const float mag = __expf(lr * dt), abr = mag * cs, abi = mag * sn;
    const float den = lr * lr + li * li, nr = abr - 1.0f, ni = abi, cr = (nr * lr + ni * li) / den, ci = (ni * lr - nr * li) / den;
    float Bcr[16], Bci[16];
#pragma unroll
    for (int c = 0; c < 16; ++c) { const float br = a.b_re[(g * 64 + p) * 16 + c], bi = a.b_im[(g * 64 + p) * 16 + c]; Bcr[c] = cr * br - ci * bi; Bci[c] = cr * bi + ci * br;
        CC[c][p] = a.c_re[(g * 16 + c) * 64 + p]; CC[c][64 + p] = -a.c_im[(g * 16 + c) * 64 + p]; }
    float hr = 0.f, hi = 0.f;
    const bf16_t* U = a.UG + (size_t)(b * 64 + g) * L_ * 16;
    for (int t0 = 0; t0 < L_; t0 += 16) {
        __syncthreads();
#pragma unroll
        for (int q = 0; q < 4; ++q) { const int idx = p * 4 + q; Us[idx >> 4][idx & 15] = bf2f(U[(size_t)t0 * 16 + idx]); }
        __syncthreads();
#pragma unroll
        for (int s = 0; s < 16; ++s) { float br = 0.f, bi = 0.f;
#pragma unroll
            for (int c = 0; c < 16; ++c) { br += Bcr[c] * Us[s][c]; bi += Bci[c] * Us[s][c]; }
            const float nhr = abr * hr - abi * hi + br, nhi = abr * hi + abi * hr + bi; hr = nhr; hi = nhi; H[s][p] = hr; H[s][64 + p] = hi; }
        __syncthreads();
#pragma unroll
        for (int q = 0; q < 4; ++q) { const int idx = p * 4 + q, s = idx >> 4, c = idx & 15; float y = a.d[g * 16 + c] * Us[s][c];
            for (int k = 0; k < 128; ++k) y += H[s][k] * CC[c][k];
            a.Z[(size_t)(b * L_ + t0 + s) * W5 + g * 16 + c] = (bf16_t)(pg8::cvt_pk_bf16(gelu_tanh_f(y), 0.f) & 0xffff); }
    }
}
__global__ void __launch_bounds__(128) k_hgrn_naive(const bf16_t* SQ, const float* LOGF, const bf16_t* KKR, const bf16_t* V, float* ORAW) {
    const int b = blockIdx.x >> 3, h = blockIdx.x & 7, d = threadIdx.x;
    __shared__ float fs[128], ks[128], qs[128];
    float S[128];
#pragma unroll
    for (int k = 0; k < 128; ++k) S[k] = 0.f;
    for (int t = 0; t < L_; ++t) { const size_t o = (size_t)(b * L_ + t) * HW + h * 128 + d;
        __syncthreads();
        fs[d] = __expf(LOGF[o]); ks[d] = bf2f(KKR[o]); qs[d] = bf2f(SQ[o]);
        const float v = bf2f(V[o]);
        __syncthreads();
        float acc = 0.f;
#pragma unroll
        for (int k = 0; k < 128; ++k) { S[k] = fs[k] * S[k] + ks[k] * v; acc += qs[k] * S[k]; }
        ORAW[o] = acc; }
}
__global__ void __launch_bounds__(64) k_oh_naive(const float* ORAW, const bf16_t* G, const float* norm_g, bf16_t* OH) {
    const int row = blockIdx.x >> 3, h = blockIdx.x & 7, lane = threadIdx.x; const size_t o = (size_t)row * HW + h * 128;
    const float o0 = ORAW[o + lane], o1 = ORAW[o + 64 + lane]; float s = o0 * o0 + o1 * o1;
#pragma unroll
    for (int k = 1; k < 64; k <<= 1) s += __shfl_xor(s, k);
    const float r = rsqrtf(s * (1.0f / 128.0f) + RMS_EPS);
    OH[o + lane] = (bf16_t)(pg8::cvt_pk_bf16(o0 * r * norm_g[h * 128 + lane] * bf2f(G[o + lane]), 0.f) & 0xffff);
    OH[o + 64 + lane] = (bf16_t)(pg8::cvt_pk_bf16(o1 * r * norm_g[h * 128 + 64 + lane] * bf2f(G[o + 64 + lane]), 0.f) & 0xffff);
}
__global__ void k_conv_naive(const bf16_t* UPQ, const float* cw, const float* cb, bf16_t* ACT, int row0) {
    const int j = blockIdx.x * blockDim.x + threadIdx.x, t = blockIdx.y; if (j >= FF) return;
    const int cg = 256 * (j >> 7) + (j & 127), cv = cg + 128; float g = cb[j], v = cb[FF + j];
#pragma unroll
    for (int k = 0; k < 3; ++k) { const int tt = t - 2 + k; if (tt >= 0) { g += cw[k * NUP + j] * bf2f(UPQ[(size_t)tt * NUP + cg]); v += cw[k * NUP + FF + j] * bf2f(UPQ[(size_t)tt * NUP + cv]); } }
    ACT[(size_t)(row0 + t) * FF + j] = (bf16_t)(pg8::cvt_pk_bf16(silu_f(g) * v, 0.f) & 0xffff);
}
__global__ void __launch_bounds__(256) k_final(float* out, const float* ssq, const float* g) {
    const int row = blockIdx.x; const float r = rsqrtf(ssq[row] * (1.0f / D_) + RMS_EPS);
    f32x4* o = (f32x4*)(out + (size_t)row * D_); const f32x4* gg = (const f32x4*)g;
    for (int i = threadIdx.x; i < D_ / 4; i += 256) o[i] = o[i] * r * gg[i];
}


typedef pg8::bf16x8 bf16x8;
typedef short s16x4_t __attribute__((ext_vector_type(4)));
__device__ __forceinline__ bf16x8 tr_pair(const LAS unsigned char* p0, const LAS unsigned char* p1) {
    const s16x4_t lo = __builtin_bit_cast(s16x4_t, __builtin_amdgcn_ds_read_tr16_b64_v4i16((LAS s16x4_t*)p0));
    const s16x4_t hi = __builtin_bit_cast(s16x4_t, __builtin_amdgcn_ds_read_tr16_b64_v4i16((LAS s16x4_t*)p1));
    return __builtin_shufflevector(lo, hi, 0, 1, 2, 3, 4, 5, 6, 7);
}
#define MFMA16(a, b, c) __builtin_amdgcn_mfma_f32_16x16x32_bf16((a), (b), (c), 0, 0, 0)

struct HgrnArgs { const bf16_t* QD; const bf16_t* KD; const float* EGL; const bf16_t* V; bf16_t* ORAW; float* SSQH; };
#define WG_BAR() do { asm volatile("s_waitcnt lgkmcnt(0)" ::: "memory"); __builtin_amdgcn_s_barrier(); asm volatile("" ::: "memory"); } while (0)
constexpr int HG_QS = 0, HG_KS = 17408, HG_VS = 34816, HG_TILE = 39936, HG_PS = 3 * HG_TILE, HG_ST = HG_PS + 2 * 9216, HG_END = HG_ST + 2 * 8704;
__device__ __forceinline__ void hgrn_unit(const HgrnArgs& a, LAS unsigned char* lds, int unit) {
    int tid_ = threadIdx.x; asm volatile("" : "+v"(tid_));
    const int tid = tid_, lane = tid & 63, w = __builtin_amdgcn_readfirstlane(tid >> 6), li = lane & 15, q4 = lane >> 4;
    const int b = unit >> 5, h = (unit >> 2) & 7, dq = unit & 3;
    const size_t rowbase = (size_t)b * L_;
    const int colq = h * 128, colv = h * 128 + dq * 32;
    for (int i = tid; i < 2 * 8704 / 4; i += 512) ((LAS unsigned*)(lds + HG_ST))[i] = 0u;
    u32x4 rqA[2], rkA[2], rvA = (u32x4){0u, 0u, 0u, 0u}, rqB[2], rkB[2], rvB = (u32x4){0u, 0u, 0u, 0u};
#define HG_LOAD(rq, rk, rv, c) do { const size_t r0 = rowbase + (size_t)(c) * 64; _Pragma("unroll") for (int i = 0; i < 2; ++i) { const int idx = tid + 512 * i, row = idx >> 4, c16 = idx & 15; \
        rq[i] = *(const u32x4*)(a.QD + (r0 + row) * HW + colq + c16 * 8); rk[i] = *(const u32x4*)(a.KD + (r0 + row) * HW + colq + c16 * 8); } \
        if (tid < 256) rv = *(const u32x4*)(a.V + (r0 + (tid >> 2)) * HW + colv + (tid & 3) * 8); } while (0)
#define HG_WRITE(rq, rk, rv, tb) do { LAS unsigned char* tp = lds + (tb) * HG_TILE; _Pragma("unroll") for (int i = 0; i < 2; ++i) { const int idx = tid + 512 * i, row = idx >> 4, c16 = idx & 15; \
        *(LAS u32x4*)(tp + HG_QS + (row * 136 + c16 * 8) * 2) = rq[i]; *(LAS u32x4*)(tp + HG_KS + (row * 136 + c16 * 8) * 2) = rk[i]; } \
        if (tid < 256) *(LAS u32x4*)(tp + HG_VS + ((tid >> 2) * 40 + (tid & 3) * 8) * 2) = rv; } while (0)
    HG_LOAD(rqA, rkA, rvA, 0); HG_LOAD(rqB, rkB, rvB, 1); HG_WRITE(rqA, rkA, rvA, 0); HG_WRITE(rqB, rkB, rvB, 1);
    HG_LOAD(rqA, rkA, rvA, 2); HG_LOAD(rqB, rkB, rvB, 3);
    __syncthreads();
    f32x4 Sacc[2] = {(f32x4){0.f, 0.f, 0.f, 0.f}, (f32x4){0.f, 0.f, 0.f, 0.f}};
    f32x4 eglA = *(const f32x4*)(a.EGL + (size_t)(b * 64) * HW + colq + w * 16 + 4 * q4), eglB = *(const f32x4*)(a.EGL + (size_t)(b * 64 + 1) * HW + colq + w * 16 + 4 * q4);
    int tb3 = 0;
#define HG_CHUNK(c, RQ, RK, RV, EGL4) do { \
        const int p = (c) & 1; const LAS unsigned char* tp = lds + tb3 * HG_TILE; const LAS unsigned char* QS = tp + HG_QS; const LAS unsigned char* KS = tp + HG_KS; const LAS unsigned char* VS = tp + HG_VS; \
        LAS unsigned char* PSp = lds + HG_PS + p * 9216; const LAS unsigned char* STr = lds + HG_ST + p * 8704; LAS unsigned char* STw = lds + HG_ST + (p ^ 1) * 8704; \
          \
        _Pragma("unroll") for (int tt = 0; tt < 2; ++tt) { const int t = 2 * w + tt, sb = t >> 2, tbk = t & 3; f32x4 acc = (f32x4){0.f, 0.f, 0.f, 0.f}; \
            if (sb <= tbk) { _Pragma("unroll") for (int ks = 0; ks < 4; ++ks) { const bf16x8 A = *(const LAS bf16x8*)(KS + ((sb * 16 + li) * 136 + ks * 32 + 8 * q4) * 2), B = *(const LAS bf16x8*)(QS + ((tbk * 16 + li) * 136 + ks * 32 + 8 * q4) * 2); acc = MFMA16(A, B, acc); } } \
            const int s0 = sb * 16 + 4 * q4, tq = tbk * 16 + li; float mm[4]; \
            _Pragma("unroll") for (int r = 0; r < 4; ++r) mm[r] = (s0 + r <= tq) ? acc[r] : 0.f; \
            u32x2 o; o.x = pg8::cvt_pk_bf16(mm[0], mm[1]); o.y = pg8::cvt_pk_bf16(mm[2], mm[3]); *(LAS u32x2*)(PSp + (tq * 72 + s0) * 2) = o; } \
        f32x4 dS[2]; \
        _Pragma("unroll") for (int nb = 0; nb < 2; ++nb) { f32x4 acc = (f32x4){0.f, 0.f, 0.f, 0.f}; \
            _Pragma("unroll") for (int ks = 0; ks < 2; ++ks) { const LAS unsigned char* kp = KS + ((ks * 32 + 8 * q4 + (li >> 2)) * 136 + w * 16 + 4 * (li & 3)) * 2; const bf16x8 A = tr_pair(kp, kp + 4 * 136 * 2); \
                const LAS unsigned char* vp = VS + ((ks * 32 + 8 * q4 + (li >> 2)) * 40 + nb * 16 + 4 * (li & 3)) * 2; const bf16x8 B = tr_pair(vp, vp + 4 * 40 * 2); acc = MFMA16(A, B, acc); } \
            dS[nb] = acc; } \
        WG_BAR(); \
          \
        { const int tbo = w >> 1, nb = w & 1; f32x4 acc = (f32x4){0.f, 0.f, 0.f, 0.f}; \
            _Pragma("unroll") for (int ks = 0; ks < 2; ++ks) { if (ks == 0 || tbo >= 2) { const bf16x8 A = *(const LAS bf16x8*)(PSp + ((tbo * 16 + li) * 72 + ks * 32 + 8 * q4) * 2); \
                const LAS unsigned char* vp = VS + ((ks * 32 + 8 * q4 + (li >> 2)) * 40 + nb * 16 + 4 * (li & 3)) * 2; const bf16x8 B = tr_pair(vp, vp + 4 * 40 * 2); acc = MFMA16(B, A, acc); } } \
            _Pragma("unroll") for (int ks = 0; ks < 4; ++ks) { const bf16x8 A = *(const LAS bf16x8*)(QS + ((tbo * 16 + li) * 136 + ks * 32 + 8 * q4) * 2), B = *(const LAS bf16x8*)(STr + ((nb * 16 + li) * 136 + ks * 32 + 8 * q4) * 2); acc = MFMA16(B, A, acc); } \
              \
            const size_t rt = rowbase + (size_t)(c) * 64 + tbo * 16 + li; \
            { u32x2 ob; ob.x = pg8::cvt_pk_bf16(acc[0], acc[1]); ob.y = pg8::cvt_pk_bf16(acc[2], acc[3]); *(u32x2*)(a.ORAW + rt * HW + colv + nb * 16 + 4 * q4) = ob; } float ss = (acc[0] * acc[0] + acc[1] * acc[1]) + (acc[2] * acc[2] + acc[3] * acc[3]); ss += __shfl_xor(ss, 16); ss += __shfl_xor(ss, 32); \
            if (q4 == 0) a.SSQH[(rt * 8 + h) * 8 + dq * 2 + nb] = ss; } \
        _Pragma("unroll") for (int nb = 0; nb < 2; ++nb) { Sacc[nb] = (Sacc[nb] + dS[nb]) * EGL4; \
            u32x2 o; o.x = pg8::cvt_pk_bf16(Sacc[nb][0], Sacc[nb][1]); o.y = pg8::cvt_pk_bf16(Sacc[nb][2], Sacc[nb][3]); *(LAS u32x2*)(STw + ((nb * 16 + li) * 136 + w * 16 + 4 * q4) * 2) = o; } \
        if ((c) + 2 < 64) EGL4 = *(const f32x4*)(a.EGL + (size_t)(b * 64 + (c) + 2) * HW + colq + w * 16 + 4 * q4); \
        { const int tbw = (tb3 >= 1) ? tb3 - 1 : 2;                     \
          if ((c) + 2 < 64) HG_WRITE(RQ, RK, RV, tbw); \
          if ((c) + 4 < 64) HG_LOAD(RQ, RK, RV, (c) + 4); } \
        tb3 = (tb3 == 2) ? 0 : tb3 + 1; \
    } while (0)
    for (int c = 0; c < 64; c += 2) { HG_CHUNK(c, rqA, rkA, rvA, eglA); HG_CHUNK(c + 1, rqB, rkB, rvB, eglB); }
#undef HG_CHUNK
#undef HG_LOAD
#undef HG_WRITE
}
__device__ __forceinline__ void oh_rows(const bf16_t* ORAW, const float* SSQH, const bf16_t* G, const float* norm_g, bf16_t* OH, int gw, int ngw, int lane) {
    for (int row = gw; row < T_; row += ngw) { const int hcol = lane * 16, h = lane >> 3; const size_t o = (size_t)row * HW + hcol;
        const f32x4 p0 = *(const f32x4*)(SSQH + ((size_t)row * 8 + h) * 8), p1 = *(const f32x4*)(SSQH + ((size_t)row * 8 + h) * 8 + 4);
        const float r = rsqrtf(((p0[0] + p0[1]) + (p0[2] + p0[3]) + (p1[0] + p1[1]) + (p1[2] + p1[3])) * (1.0f / 128.0f) + RMS_EPS);
#pragma unroll
        for (int hh = 0; hh < 2; ++hh) { float ov[8]; unpack8(*(const u32x4*)(ORAW + o + hh * 8), ov); const f32x4 a0 = (f32x4){ov[0], ov[1], ov[2], ov[3]}, a1 = (f32x4){ov[4], ov[5], ov[6], ov[7]}, n0 = *(const f32x4*)(norm_g + hcol + hh * 8), n1 = *(const f32x4*)(norm_g + hcol + hh * 8 + 4);
            float g[8], v[8]; unpack8(*(const u32x4*)(G + o + hh * 8), g);
#pragma unroll
            for (int j = 0; j < 4; ++j) { v[j] = a0[j] * r * n0[j] * g[j]; v[4 + j] = a1[j] * r * n1[j] * g[4 + j]; }
            *(u32x4*)(OH + o + hh * 8) = pack8(v); } }
}

constexpr int S5_KT = 0, S5_E = 9216, S5_F = S5_E + 65536, S5_AB = S5_F + 65536, S5_GSTRIDE = S5_AB + 512;
struct S5In { const float *a_re, *a_im, *log_dt, *b_re, *b_im, *c_re, *c_im, *d; };
__device__ __forceinline__ void s5_tables(const S5In& in, unsigned char* tabs, LAS unsigned char* lds, int g) {
    const int tid = threadIdx.x;
    LAS float* PWr = (LAS float*)lds; LAS float* PWi = PWr + 17 * 64; LAS float* Bcr = PWi + 17 * 64; LAS float* Bci = Bcr + 1024; LAS float* Ccr = Bci + 1024; LAS float* Cci = Ccr + 1024;
    unsigned char* tab = tabs + (size_t)g * S5_GSTRIDE;
    if (tid < 64) { const int p = tid; const float lr = fminf(in.a_re[g * 64 + p], -1e-4f), li = in.a_im[g * 64 + p], dt = __expf(in.log_dt[g]), th = li * dt, mm = lr * dt;
        for (int j = 0; j <= 16; ++j) { float sn, cs; sincos_rev(th * (float)j, sn, cs); const float mag = __expf(mm * (float)j); PWr[j * 64 + p] = mag * cs; PWi[j * 64 + p] = mag * sn; }
        const float abr = PWr[64 + p], abi = PWi[64 + p], den = lr * lr + li * li, nr = abr - 1.0f, ni = abi, cr = (nr * lr + ni * li) / den, ci = (ni * lr - nr * li) / den;
        for (int c = 0; c < 16; ++c) { const float br = in.b_re[(g * 64 + p) * 16 + c], bi = in.b_im[(g * 64 + p) * 16 + c]; Bcr[p * 16 + c] = cr * br - ci * bi; Bci[p * 16 + c] = cr * bi + ci * br; }
        ((float*)(tab + S5_AB))[2 * p] = PWr[16 * 64 + p]; ((float*)(tab + S5_AB))[2 * p + 1] = PWi[16 * 64 + p]; }
    for (int i = tid; i < 1024; i += 512) { Ccr[i] = in.c_re[g * 1024 + i]; Cci[i] = in.c_im[g * 1024 + i]; }
    __syncthreads();
    bf16_t* KT = (bf16_t*)(tab + S5_KT); bf16_t* E = (bf16_t*)(tab + S5_E); bf16_t* F = (bf16_t*)(tab + S5_F);
    if (tid < 256) KT[tid] = 0;
    for (int i = 0; i < 8; ++i) { const int e = tid * 8 + i, tau = e >> 8, c = (e >> 4) & 15, cp = e & 15; float acc = 0.f;
        for (int p = 0; p < 64; ++p) { const float pr = PWr[tau * 64 + p], pi = PWi[tau * 64 + p], br = Bcr[p * 16 + cp], bi = Bci[p * 16 + cp]; const float wr_ = pr * br - pi * bi, wi_ = pr * bi + pi * br;
            acc += Ccr[c * 64 + p] * wr_ - Cci[c * 64 + p] * wi_; }
        if (tau == 0 && c == cp) acc += in.d[g * 16 + c];
        KT[256 + e] = (bf16_t)(pg8::cvt_pk_bf16(acc, 0.f) & 0xffff); }
    for (int i = 0; i < 64; ++i) { const int e = tid + 512 * i, r = e >> 8, k = e & 255, s = k >> 4, cp = k & 15, p = r & 63; const float pr = PWr[(15 - s) * 64 + p], pi = PWi[(15 - s) * 64 + p], br = Bcr[p * 16 + cp], bi = Bci[p * 16 + cp];
        E[e] = (bf16_t)(pg8::cvt_pk_bf16(r < 64 ? pr * br - pi * bi : pr * bi + pi * br, 0.f) & 0xffff); }
    for (int i = 0; i < 64; ++i) { const int e = tid + 512 * i, row = e >> 7, k = e & 127, t = row >> 4, c = row & 15, p = k & 63; const float pr = PWr[(t + 1) * 64 + p], pi = PWi[(t + 1) * 64 + p], cr = Ccr[c * 64 + p], ci = Cci[c * 64 + p];
        F[e] = (bf16_t)(pg8::cvt_pk_bf16(k < 64 ? cr * pr - ci * pi : -(cr * pi + ci * pr), 0.f) & 0xffff); }
    __syncthreads();
}
struct S5FArgs { const bf16_t* UG; const unsigned char* tabs; bf16_t* Z; };
constexpr int S5_US = 0  , S5_EUS = 67584, S5_HS = 101376, S5_KTS = 118784, S5_TOT = 127488, S5_LDS_END = 131584;
__device__ __forceinline__ void s5_unit(const S5FArgs& a, LAS unsigned char* lds, int unit) {
    int tid_ = threadIdx.x; asm volatile("" : "+v"(tid_));
    const int tid = tid_, lane = tid & 63, w = __builtin_amdgcn_readfirstlane(tid >> 6), li = lane & 15, q4 = lane >> 4;
    const int b = unit >> 6, g = unit & 63;
    const unsigned char* tab = a.tabs + (size_t)g * S5_GSTRIDE;
    const bf16_t* E = (const bf16_t*)(tab + S5_E); const bf16_t* F = (const bf16_t*)(tab + S5_F);
    const bf16_t* U = a.UG + (size_t)(b * 64 + g) * L_ * 16;
    u32x4 ru[4];
#define S5_ULOAD(seg) do { _Pragma("unroll") for (int i = 0; i < 4; ++i) ru[i] = *(const u32x4*)(U + (size_t)(seg) * 16384 + (size_t)(tid + 512 * i) * 8); } while (0)
#define S5_UWRITE(buf) do { _Pragma("unroll") for (int i = 0; i < 4; ++i) { const int idx = tid + 512 * i, n = idx >> 5, c16 = idx & 31; *(LAS u32x4*)(lds + S5_US + (buf) * 33792 + (n * 264 + c16 * 8) * 2) = ru[i]; } } while (0)
    S5_ULOAD(0);
    WG_BAR();
    for (int i = tid; i < 544; i += 512) *(LAS u32x4*)(lds + S5_KTS + i * 16) = *(const u32x4*)(tab + S5_KT + i * 16);
    bf16x8 Ef[8], Ff[2][4];
#pragma unroll
    for (int ks = 0; ks < 8; ++ks) Ef[ks] = *(const bf16x8*)(E + (w * 16 + li) * 256 + ks * 32 + 8 * q4);
#pragma unroll
    for (int tt = 0; tt < 2; ++tt) { const int t = tt ? 15 - w : w;
#pragma unroll
        for (int ks = 0; ks < 4; ++ks) Ff[tt][ks] = *(const bf16x8*)(F + (t * 16 + li) * 128 + ks * 32 + 8 * q4); }
    const float abr = ((const float*)(tab + S5_AB))[2 * lane], abi = ((const float*)(tab + S5_AB))[2 * lane + 1];
    float a8r = abr, a8i = abi;
#pragma unroll
    for (int k = 0; k < 3; ++k) { const float nr = a8r * a8r - a8i * a8i, ni = 2.0f * a8r * a8i; a8r = nr; a8i = ni; }
    float hsr = 0.f, hsi = 0.f;
    S5_UWRITE(0); S5_ULOAD(1);
    for (int seg = 0; seg < 4; ++seg) {
        const LAS unsigned char* US = lds + S5_US + (seg & 1) * 33792;
        WG_BAR();
#pragma unroll
        for (int nb = 0; nb < 4; ++nb) { f32x4 acc = (f32x4){0.f, 0.f, 0.f, 0.f};
#pragma unroll
            for (int ks = 0; ks < 8; ++ks) { const bf16x8 B = *(const LAS bf16x8*)(US + ((nb * 16 + li) * 264 + ks * 32 + 8 * q4) * 2); acc = MFMA16(Ef[ks], B, acc); }
            *(LAS f32x4*)(lds + S5_EUS + ((nb * 16 + li) * 132 + w * 16 + 4 * q4) * 4) = acc; }
        WG_BAR();
        float lr[8], lim[8];
        { float er[8], ei[8];
#pragma unroll
          for (int j = 0; j < 8; ++j) { er[j] = *(const LAS float*)(lds + S5_EUS + ((8 * w + j) * 132 + lane) * 4); ei[j] = *(const LAS float*)(lds + S5_EUS + ((8 * w + j) * 132 + 64 + lane) * 4); }
          float hr = 0.f, hi = 0.f;
#pragma unroll
          for (int j = 0; j < 8; ++j) { lr[j] = hr; lim[j] = hi; const float nhr = abr * hr - abi * hi + er[j], nhi = abr * hi + abi * hr + ei[j]; hr = nhr; hi = nhi; }
          *(LAS float*)(lds + S5_TOT + (w * 128 + lane) * 4) = hr; *(LAS float*)(lds + S5_TOT + (w * 128 + 64 + lane) * 4) = hi; }
        WG_BAR();
        { float gr = hsr, gi = hsi, mr = 0.f, mi = 0.f;
#pragma unroll
          for (int k = 0; k < 8; ++k) { if (k == w) { mr = gr; mi = gi; } const float tr_ = *(const LAS float*)(lds + S5_TOT + (k * 128 + lane) * 4), ti_ = *(const LAS float*)(lds + S5_TOT + (k * 128 + 64 + lane) * 4);
              const float nr = a8r * gr - a8i * gi + tr_, ni = a8r * gi + a8i * gr + ti_; gr = nr; gi = ni; }
          hsr = gr; hsi = gi;
#pragma unroll
          for (int j = 0; j < 8; ++j) { const int n = 8 * w + j;
              *(LAS bf16_t*)(lds + S5_HS + (n * 136 + lane) * 2) = (bf16_t)(pg8::cvt_pk_bf16(lr[j] + mr, 0.f) & 0xffff); *(LAS bf16_t*)(lds + S5_HS + (n * 136 + 64 + lane) * 2) = (bf16_t)(pg8::cvt_pk_bf16(lim[j] + mi, 0.f) & 0xffff);
              const float nr = abr * mr - abi * mi, ni = abr * mi + abi * mr; mr = nr; mi = ni; } }
        WG_BAR();
#pragma unroll
        for (int tt = 0; tt < 2; ++tt) { const int t = tt ? 15 - w : w;
#pragma unroll
            for (int nb = 0; nb < 4; ++nb) { f32x4 acc = (f32x4){0.f, 0.f, 0.f, 0.f};
                for (int ks = 0; ks <= (t >> 1); ++ks) { const int ti = t - 2 * ks - (q4 >> 1) + 1; const bf16x8 A = *(const LAS bf16x8*)(lds + S5_KTS + (ti * 256 + li * 16 + 8 * (q4 & 1)) * 2);
                    const bf16x8 B = *(const LAS bf16x8*)(US + ((nb * 16 + li) * 264 + ks * 32 + 8 * q4) * 2); acc = MFMA16(A, B, acc); }
#pragma unroll
                for (int ks = 0; ks < 4; ++ks) { const bf16x8 B = *(const LAS bf16x8*)(lds + S5_HS + ((nb * 16 + li) * 136 + ks * 32 + 8 * q4) * 2); acc = MFMA16(Ff[tt][ks], B, acc); }
                const size_t tok = (size_t)b * L_ + seg * 1024 + (nb * 16 + li) * 16 + t; u32x2 o; o.x = pg8::cvt_pk_bf16(gelu_tanh_f(acc[0]), gelu_tanh_f(acc[1])); o.y = pg8::cvt_pk_bf16(gelu_tanh_f(acc[2]), gelu_tanh_f(acc[3]));
                *(u32x2*)(a.Z + tok * W5 + g * 16 + 4 * q4) = o; } }
        if (seg + 1 < 4) { S5_UWRITE((seg + 1) & 1); if (seg + 2 < 4) S5_ULOAD(seg + 2); }
    }
#undef S5_ULOAD
#undef S5_UWRITE
}
__global__ void __launch_bounds__(512, 2) k_hgrn_fast(HgrnArgs a) { extern __shared__ __attribute__((aligned(16))) unsigned char lds[]; for (int u = blockIdx.x; u < 128; u += gridDim.x) { hgrn_unit(a, (LAS unsigned char*)lds, u); __syncthreads(); } }
__global__ void __launch_bounds__(512, 2) k_s5_fast(S5FArgs a) { extern __shared__ __attribute__((aligned(16))) unsigned char lds[]; for (int u = blockIdx.x; u < 256; u += gridDim.x) s5_unit(a, (LAS unsigned char*)lds, u); }
__global__ void __launch_bounds__(512, 2) k_s5_tab(S5In in, unsigned char* tabs) { extern __shared__ __attribute__((aligned(16))) unsigned char lds[]; s5_tables(in, tabs, (LAS unsigned char*)lds, blockIdx.x); }
__global__ void __launch_bounds__(512, 2) k_oh_fast(const bf16_t* ORAW, const float* SSQH, const bf16_t* G, const float* norm_g, bf16_t* OH) { oh_rows(ORAW, SSQH, G, norm_g, OH, blockIdx.x * 8 + (threadIdx.x >> 6), gridDim.x * 8, threadIdx.x & 63); }

__host__ __device__ __forceinline__ pg8::Gemm mk_gemm(const void* A, const void* Bt, int M, int N, int K) { pg8::Gemm g{}; g.A = g.A2 = (const bf16_t*)A; g.Bt = g.Bt2 = (const bf16_t*)Bt; g.M = M; g.N = N; g.K = K; return g; }

#define XB_TMO      128
#define XB_XCNT(j)  (256  + 64 * (j))
#define XB_XSUB(j)  (1280 + 64 * (j))
#define XB_XGEN(j)  (2304 + 64 * (j))
#define XB_TOP      3328
#define XB_TOPGEN   3392
#define XCD_BAR_WORDS 3456
#define XB_SPIN_CAP (1u << 18)
__device__ __forceinline__ unsigned xb_ld(unsigned* p)              { return __hip_atomic_load(p, __ATOMIC_RELAXED, __HIP_MEMORY_SCOPE_AGENT); }
__device__ __forceinline__ unsigned xb_add(unsigned* p, unsigned v) { return __hip_atomic_fetch_add(p, v, __ATOMIC_RELAXED, __HIP_MEMORY_SCOPE_AGENT); }
__device__ __forceinline__ unsigned xb_xcc_id() { return (unsigned)__builtin_amdgcn_s_getreg((3 << 11) | 20) & 0xFu; }
#define XB_SPIN(cond, bar) do { unsigned _sp = 0; while (cond) { __builtin_amdgcn_s_sleep(1); \
    if ((++_sp & 255u) == 0u) { if (xb_ld(&(bar)[XB_TMO])) break; if (_sp > XB_SPIN_CAP) { atomicAdd(&(bar)[XB_TMO], 1u); break; } } } } while (0)
struct XcdBarrier { unsigned* bar; unsigned x; volatile LAS unsigned* st; };
__device__ __forceinline__ XcdBarrier xcd_barrier_post(unsigned* bar, volatile LAS unsigned* st) {
    XcdBarrier b; b.bar = bar; b.x = xb_xcc_id(); b.st = st;
    if (threadIdx.x == 0) (void)xb_add(&bar[XB_XCNT(b.x)], 1u);
    return b;
}
__device__ __forceinline__ void xcd_barrier_complete(unsigned* bar, unsigned x, unsigned& nloc, unsigned& nx) {
    const unsigned G = gridDim.x * gridDim.y * gridDim.z;
    unsigned sum, cnt, mine, sp = 0u;
    for (;;) {
        sum = 0u; cnt = 0u; mine = 0u;
#pragma unroll
        for (unsigned j = 0; j < 16; ++j) { const unsigned c = xb_ld(&bar[XB_XCNT(j)]); sum += c; cnt += (c > 0u) ? 1u : 0u; mine = (j == x) ? c : mine; }
        if (sum == G) break;
        __builtin_amdgcn_s_sleep(1);
        if ((++sp & 255u) == 0u) { if (xb_ld(&bar[XB_TMO])) break; if (sp > XB_SPIN_CAP) { atomicAdd(&bar[XB_TMO], 1u); break; } }
    }
    nloc = mine > 0u ? mine : 1u; nx = cnt > 0u ? cnt : 1u;
}
__device__ __forceinline__ void xcd_barrier(const XcdBarrier& b) {
    asm volatile("s_waitcnt vmcnt(0)" ::: "memory");
    __syncthreads();
    if (threadIdx.x == 0) {
        unsigned* bar = b.bar;
        __builtin_amdgcn_s_waitcnt(0);
        unsigned nloc = b.st[0], nx = b.st[1];
        if (nloc == 0u) { xcd_barrier_complete(bar, b.x, nloc, nx); b.st[0] = nloc; b.st[1] = nx; }
        const unsigned old = xb_add(&bar[XB_XSUB(b.x)], 1u);
        const unsigned gen = old / nloc;
        if (old + 1u == (gen + 1u) * nloc) {
            __builtin_amdgcn_fence(__ATOMIC_RELEASE, "agent");
            asm volatile("s_waitcnt vmcnt(0)" ::: "memory");
            const unsigned og = xb_add(&bar[XB_TOP], 1u);
            const unsigned tg = og / nx;
            if (og + 1u == (tg + 1u) * nx) xb_add(&bar[XB_TOPGEN], 1u);
            else XB_SPIN(xb_ld(&bar[XB_TOPGEN]) == tg, bar);
            __builtin_amdgcn_fence(__ATOMIC_ACQUIRE, "agent");
            xb_add(&bar[XB_XGEN(b.x)], 1u);
            asm volatile("s_waitcnt vmcnt(0)" ::: "memory");
        } else {
            XB_SPIN(xb_ld(&bar[XB_XGEN(b.x)]) == gen, bar);
            __builtin_amdgcn_fence(__ATOMIC_ACQUIRE, "agent");
            asm volatile("s_waitcnt vmcnt(0)" ::: "memory");
        }
    }
    __syncthreads();
}
constexpr int CW_BAR = 4096;
constexpr int MISC_OFF = 163584;
#ifndef HG_GATE_UNITS
#define HG_GATE_UNITS 4
#endif
#ifndef N_CG_SYNC
#define N_CG_SYNC 0
#endif
struct MegaArgs { const float* in[24]; float* out; unsigned char* ws; };
__device__ __forceinline__ const float* in_ptr(const MegaArgs& a, int i) { unsigned long long p = (unsigned long long)a.in[i]; asm volatile("" : "+s"(p)); return (const float*)(const __attribute__((address_space(1))) float*)p; }
__global__ void __launch_bounds__(512, 2) k_mega(MegaArgs a) {
    extern __shared__ __attribute__((aligned(16))) unsigned char lds_[];
    LAS unsigned char* lds = (LAS unsigned char*)lds_;
    cg::grid_group grid = cg::this_grid();
    volatile LAS unsigned* misc = (volatile LAS unsigned*)(lds + MISC_OFF);
    if (threadIdx.x < 64) misc[threadIdx.x] = 0u;
    __syncthreads();
    unsigned char* ws = a.ws; float* out = a.out;
#define GASP __attribute__((address_space(1)))
#define PHASE_PTRS() do { unsigned long long w_ = (unsigned long long)a.ws, o_ = (unsigned long long)a.out; asm volatile("" : "+s"(w_), "+s"(o_)); ws = (unsigned char*)(GASP unsigned char*)w_; out = (float*)(GASP float*)o_; } while (0)
#define INP(i) in_ptr(a, (i))
    XcdBarrier bar = xcd_barrier_post((unsigned*)(ws + WS_CTL) + CW_BAR, misc + 8);
    int seam = 0;
#ifndef PROBE_PHASE
#define PROBE_PHASE -1
#endif
#ifndef REPEAT_PHASE
#define REPEAT_PHASE -1
#endif
#ifndef SKEW_LO
#define SKEW_LO 0
#define SKEW_HI 7
#endif
#ifndef SKEW_SPLIT
#define SKEW_SPLIT 0
#define SKEW_SPLIT_NEG 0
#endif
#define REPS(k) _Pragma("unroll") for (int rep = 0; rep < ((REPEAT_PHASE == (k)) ? 2 : 1); ++rep)
    unsigned long long* tsb = (unsigned long long*)(a.ws + 15 * MiB);
#define STAMP() do { if (PROBE_PHASE >= 0 && blockIdx.x == 0 && threadIdx.x == 0) tsb[seam] = __builtin_amdgcn_s_memrealtime(); } while (0)
#define SEAM() do { if (REPEAT_PHASE == 70 && threadIdx.x == 0) { asm volatile("s_waitcnt vmcnt(0)" ::: "memory"); const unsigned t_ = (unsigned)__builtin_amdgcn_s_memrealtime(); if (SKEW_SPLIT > 0) atomicMax(&bar.bar[3600 + 2 * seam + ((int)blockIdx.x >= SKEW_SPLIT ? 1 : 0)], t_); else { atomicMax(&bar.bar[3600 + 2 * seam], t_); atomicMax(&bar.bar[3601 + 2 * seam], 0xFFFFFFFFu - t_); } } \
    if (seam < N_CG_SYNC) grid.sync(); else xcd_barrier(bar); ++seam; STAMP(); } while (0)
#define SSQ2 ((float*)(ws + CTL_SSQ2))
#define SSQ3 ((float*)(ws + CTL_SSQ3))
#define GS5P ((bf16_t*)out)
#define GHP ((bf16_t*)out + (size_t)T_ * D_)
    const int G = (int)gridDim.x, bx = (int)blockIdx.x, wave = __builtin_amdgcn_readfirstlane((int)(threadIdx.x >> 6)), lane = (int)(threadIdx.x & 63);
    STAMP();
    PHASE_PTRS();
    REPS(0) {
    if (bx >= G - 64) { S5In in{}; in.a_re = INP(3); in.a_im = INP(4); in.log_dt = INP(5); in.b_re = INP(6); in.b_im = INP(7); in.c_re = INP(8); in.c_im = INP(9); in.d = INP(10); s5_tables(in, ws + WS_S5TAB, lds, bx - (G - 64)); }
    { PrepArgs p{}; p.x = INP(0); p.ln_mix_g = INP(1); p.w_in = INP(2); p.w_glu = INP(11); p.w_ps5 = INP(13); p.w_ph = INP(16); p.w_out = INP(17); p.ln_ffn_g = INP(18); p.w_up = INP(19); p.w_down = INP(22); p.lb_logits = INP(14); p.ws = ws;
      prep_phase(p, lds, bx * 8 + wave, G * 8, lane, 64 * 8); }
    __syncthreads(); }
    SEAM();
    PHASE_PTRS();
    REPS(1) { EpiProjF E{}; E.rstd = (const float*)(ws + WS_RSTD1); E.lb = (const float*)(ws + WS_LB); E.UG = (bf16_t*)(ws + WS_UG); E.QD = (bf16_t*)(ws + WS_QD); E.KD = (bf16_t*)(ws + WS_KD); E.V = (bf16_t*)(ws + WS_V);
      E.G = (bf16_t*)(ws + WS_G); E.GS5 = GS5P; E.GH = GHP; E.EGL = (float*)(ws + WS_EGL);
      const pg8::Gemm g = mk_gemm(ws + WS_XB, ws + WS_WIN, T_, 20 * 256, D_); pg8::StaticOrder S; S.init(g.M, g.N, G, bx); pg8::gemm_phase<EpiProjF, pg8::StaticOrder, true, true>(lds, g, S, E); }
    if (REPEAT_PHASE == 30) { EpiNull E{}; E.sink = (float*)(ws + 14 * MiB); const pg8::Gemm g = mk_gemm(ws + WS_XB, ws + WS_WIN, T_, NIN, D_); pg8::StaticOrder S; S.init(g.M, g.N, G, bx); pg8::gemm_phase<EpiNull, pg8::StaticOrder, true, true>(lds, g, S, E); }
    if (REPEAT_PHASE == 31) { EpiNull E{}; E.sink = (float*)(ws + 14 * MiB); const pg8::Gemm g = mk_gemm(ws + WS_XB, ws + WS_WIN, T_, NIN, D_); pg8::StaticOrder S; S.init(g.M, g.N, G, bx); pg8::gemm_phase<EpiNull, pg8::StaticOrder, false, false>(lds, g, S, E); }
    if (REPEAT_PHASE == 33) { EpiStoreOnly E{}; E.dst = (bf16_t*)(ws + WS_ORAW); E.nslot = 512; const pg8::Gemm g = mk_gemm(ws + WS_XB, ws + WS_WIN, T_, NIN, D_); pg8::StaticOrder S; S.init(g.M, g.N, G, bx); pg8::gemm_phase<EpiStoreOnly, pg8::StaticOrder, true, true>(lds, g, S, E); }
    if (REPEAT_PHASE == 37) { EpiStoreHalf E{}; E.dst = (bf16_t*)(ws + WS_ORAW); E.nslot = 512; const pg8::Gemm g = mk_gemm(ws + WS_XB, ws + WS_WIN, T_, NIN, D_); pg8::StaticOrder S; S.init(g.M, g.N, G, bx); pg8::gemm_phase<EpiStoreHalf, pg8::StaticOrder, true, true>(lds, g, S, E); }
    if (REPEAT_PHASE == 34) { EpiStoreFull E{}; E.dst = (bf16_t*)(ws + WS_ORAW); E.nslot = 512; const pg8::Gemm g = mk_gemm(ws + WS_XB, ws + WS_WIN, T_, NIN, D_); pg8::StaticOrder S; S.init(g.M, g.N, G, bx); pg8::gemm_phase<EpiStoreFull, pg8::StaticOrder, true, true>(lds, g, S, E); }
    SEAM();
    PHASE_PTRS();
#if P2_PREP_FIRST
    if (bx >= 128) { __syncthreads();
        int tid_ = (int)threadIdx.x; asm volatile("" : "+v"(tid_)); const int w_ = __builtin_amdgcn_readfirstlane(tid_ >> 6), ln_ = tid_ & 63; LAS float* scr = (LAS float*)(lds + w_ * 16640);
        constexpr int I_DN = (FF / 64) * (D_ / 64);
        for (int j = 0; j < (I_DN + P2_UP + 1023) / 1024; ++j) { const int r = j * 1024 + (bx - 128) * 8 + w_; if (r >= I_DN + P2_UP) break;
            if (r < I_DN) transpose_item(INP(22), nullptr, FF, D_, (bf16_t*)(ws + WS_WDOWN), 0, scr, r, ln_); else transpose_item(INP(19), INP(18), D_, NUP, (bf16_t*)(ws + WS_WUP), 2, scr, r - I_DN, ln_); } }
    __syncthreads();
#endif
    REPS(2) { __syncthreads();
    if (bx < 128) { HgrnArgs h{}; h.QD = (const bf16_t*)(ws + WS_QD); h.KD = (const bf16_t*)(ws + WS_KD); h.EGL = (const float*)(ws + WS_EGL); h.V = (const bf16_t*)(ws + WS_V); h.ORAW = (bf16_t*)(ws + WS_ORAW); h.SSQH = (float*)(ws + WS_SSQH);
        for (int r2 = 0; r2 < (REPEAT_PHASE == 20 ? 2 : 1); ++r2) for (int u = bx; u < 128; u += 128) { hgrn_unit(h, lds, u); __syncthreads(); } }
    else { S5FArgs s{}; s.UG = (const bf16_t*)(ws + WS_UG); s.tabs = ws + WS_S5TAB; s.Z = (bf16_t*)(ws + WS_Z);
        for (int r2 = 0; r2 < (REPEAT_PHASE == 21 ? 2 : 1); ++r2) for (int u = bx - 128; u < 256; u += G - 128) s5_unit(s, lds, u); } }
    { __syncthreads(); EpiProjF E{}; E.rstd = (const float*)(ws + WS_RSTD1); E.lb = (const float*)(ws + WS_LB); E.UG = (bf16_t*)(ws + WS_UG); E.QD = (bf16_t*)(ws + WS_QD); E.KD = (bf16_t*)(ws + WS_KD); E.V = (bf16_t*)(ws + WS_V);
      E.G = (bf16_t*)(ws + WS_G); E.GS5 = GS5P; E.GH = GHP; E.EGL = (float*)(ws + WS_EGL);
      const pg8::Gemm g = mk_gemm(ws + WS_XB, ws + WS_WIN, T_, NIN, D_); pg8::RangeOrder S; S.pn0 = 20;
      if (bx < 128) { S.first = bx * HG_GATE_UNITS; S.count = HG_GATE_UNITS; } else { S.first = 128 * HG_GATE_UNITS + (bx - 128) * (8 - HG_GATE_UNITS); S.count = 8 - HG_GATE_UNITS; }
      if (G == 256) pg8::gemm_phase<EpiProjF, pg8::RangeOrder, true, true>(lds, g, S, E); }
#if !P2_PREP_FIRST
    if (bx >= 128) { __syncthreads();
        int tid_ = (int)threadIdx.x; asm volatile("" : "+v"(tid_)); const int w_ = __builtin_amdgcn_readfirstlane(tid_ >> 6), ln_ = tid_ & 63; LAS float* scr = (LAS float*)(lds + w_ * 16640);
        constexpr int I_DN = (FF / 64) * (D_ / 64);
        for (int j = 0; j < (I_DN + P2_UP + 1023) / 1024; ++j) { const int r = j * 1024 + (bx - 128) * 8 + w_; if (r >= I_DN + P2_UP) break;
            if (r < I_DN) transpose_item(INP(22), nullptr, FF, D_, (bf16_t*)(ws + WS_WDOWN), 0, scr, r, ln_); else transpose_item(INP(19), INP(18), D_, NUP, (bf16_t*)(ws + WS_WUP), 2, scr, r - I_DN, ln_); } }
#endif
    SEAM();
    PHASE_PTRS();
    REPS(3) {
    oh_rows((const bf16_t*)(ws + WS_ORAW), (const float*)(ws + WS_SSQH), (const bf16_t*)(ws + WS_G), INP(15), (bf16_t*)(ws + WS_OH), bx * 8 + wave, G * 8, lane);
    { EpiGlu E{}; E.Z = (const bf16_t*)(ws + WS_Z); E.bias = INP(12); E.ZS = (bf16_t*)(ws + WS_ZS);
      const pg8::Gemm g = mk_gemm(ws + WS_Z, ws + WS_WGLU, T_, W5, W5); pg8::StaticOrder S; S.init(g.M, g.N, G, bx); pg8::gemm_phase<EpiGlu, pg8::StaticOrder, true, true>(lds, g, S, E); } }
    SEAM();
    PHASE_PTRS();
    REPS(4) { EpiMerged E{}; E.GS5 = GS5P; E.GH = GHP; E.MERGED = (bf16_t*)(ws + WS_MERGED);
      pg8::Gemm g = mk_gemm(ws + WS_ZS, ws + WS_WPS5, T_, D_, W5); g.A2 = (const bf16_t*)(ws + WS_OH); g.Bt2 = (const bf16_t*)(ws + WS_WPH);
      pg8::PairOrder S; S.init(g.M, g.N, G, bx); pg8::gemm_phase<EpiMerged, pg8::PairOrder, true, true>(lds, g, S, E); }
    SEAM();
    PHASE_PTRS();
    REPS(5) { EpiRes E{}; E.XI = INP(0); E.XIB = X_BF16_RESID ? (const bf16_t*)(ws + WS_XB2) : nullptr; E.XO = nullptr; E.XBF = (bf16_t*)(ws + WS_X1B); E.ssq = rep ? (float*)(ws + 14 * MiB) : SSQ2;
      const pg8::Gemm g = mk_gemm(ws + WS_MERGED, ws + WS_WOUT, T_, D_, D_); pg8::StaticOrder S; S.init(g.M, g.N, G, bx); pg8::gemm_phase<EpiRes, pg8::StaticOrder, true, true>(lds, g, S, E); }
    SEAM();
    PHASE_PTRS();
#ifndef STAGGER_P6
#define STAGGER_P6 0
#endif
    if (STAGGER_P6 > 0) { const unsigned long long t0 = __builtin_amdgcn_s_memrealtime(), dl = (unsigned long long)((bx >> 3) & 31) * STAGGER_P6; while (__builtin_amdgcn_s_memrealtime() - t0 < dl) __builtin_amdgcn_s_sleep(8); }
    REPS(6) { EpiUpConv E{}; E.ssq = SSQ2; E.cw = INP(20); E.cb = INP(21); E.ACT = (bf16_t*)(ws + WS_ACT); E.RAW = (bf16_t*)(ws + WS_RAW);
      const pg8::Gemm g = mk_gemm(ws + WS_X1B, ws + WS_WUP, T_, NUP, D_); pg8::StaticOrder S; S.init(g.M, g.N, G, bx); pg8::gemm_phase<EpiUpConv, pg8::StaticOrder, true, true>(lds, g, S, E); }
    SEAM();
    PHASE_PTRS();
    { const pg8::Gemm g = mk_gemm(ws + WS_ACT, ws + WS_WDOWN, T_, D_, FF); pg8::PanelOrder S; S.c = bx;
      int last_pm = -1; pg8::Unit u;
      for (int i = 0; S.next(i, u); ++i) if (u.pm != last_pm) { conv_fixup((const bf16_t*)(ws + WS_RAW), INP(20), INP(21), (bf16_t*)(ws + WS_ACT), 4 * u.pm, 4, (int)threadIdx.x, 512); last_pm = u.pm; }
      asm volatile("s_waitcnt vmcnt(0)" ::: "memory"); __syncthreads();
      EpiResFinal E{}; E.XO = out; E.X1 = (const bf16_t*)(ws + WS_X1B); E.ssq = SSQ3; E.cnt = (unsigned*)(ws + CTL_CNT7); E.gfin = INP(23); E.tmo = (unsigned*)(ws + CTL_CNT7) + 64 * 64;
      if (G == 256) pg8::gemm_phase<EpiResFinal, pg8::PanelOrder, true, true>(lds, g, S, E); }
    if (REPEAT_PHASE == 70 && threadIdx.x == 0) { asm volatile("s_waitcnt vmcnt(0)" ::: "memory"); const unsigned t_ = (unsigned)__builtin_amdgcn_s_memrealtime(); atomicMax(&bar.bar[3600 + 2 * 7], t_); atomicMax(&bar.bar[3601 + 2 * 7], 0xFFFFFFFFu - t_); }
    if (REPEAT_PHASE == 70) { xcd_barrier(bar); if (threadIdx.x == 0) { unsigned tot = 0; for (int q = SKEW_LO; q < SKEW_HI; ++q) { if (SKEW_SPLIT > 0) { const int d_ = (int)(xb_ld(&bar.bar[3601 + 2 * q]) - xb_ld(&bar.bar[3600 + 2 * q])); tot += (unsigned)(SKEW_SPLIT_NEG ? (d_ < 0 ? -d_ : 0) : (d_ > 0 ? d_ : 0)); } else tot += xb_ld(&bar.bar[3600 + 2 * q]) - (0xFFFFFFFFu - xb_ld(&bar.bar[3601 + 2 * q])); }
        const unsigned long long t0 = __builtin_amdgcn_s_memrealtime(); while (__builtin_amdgcn_s_memrealtime() - t0 < 4ull * tot) __builtin_amdgcn_s_sleep(8); } __syncthreads(); }
    if (PROBE_PHASE >= 0 && blockIdx.x == 0 && threadIdx.x == 0) { ++seam; tsb[seam] = __builtin_amdgcn_s_memrealtime(); asm volatile("s_waitcnt vmcnt(0) lgkmcnt(0)" ::: "memory");
        out[0] = (float)(tsb[PROBE_PHASE + 1] - tsb[PROBE_PHASE]) * 0.01f; }
#undef SEAM
#undef SSQ2
#undef SSQ3
#undef GS5P
#undef GHP
}

#ifndef DBG_STOP
#define DBG_STOP 0
#endif
#ifndef USE_FAST_HGRN
#define USE_FAST_HGRN 1
#endif
#ifndef USE_FUSED_CUMSUM
#define USE_FUSED_CUMSUM 1
#endif
#ifndef USE_FUSED_CONV
#define USE_FUSED_CONV 1
#endif
#ifndef USE_MEGA
#define USE_MEGA 1
#endif
#ifndef USE_FAST_S5
#define USE_FAST_S5 1
#endif
__global__ void k_dump_bf16(const bf16_t* src, size_t n, float* out) { for (size_t i = (size_t)blockIdx.x * blockDim.x + threadIdx.x; i < (size_t)T_ * D_; i += (size_t)gridDim.x * blockDim.x) out[i] = bf2f(src[i % n]); }
__global__ void k_dump_f32(const float* src, size_t n, float* out) { for (size_t i = (size_t)blockIdx.x * blockDim.x + threadIdx.x; i < (size_t)T_ * D_; i += (size_t)gridDim.x * blockDim.x) out[i] = src[i % n]; }
#define DUMP_BF16(stage, off, n) do { if (DBG_STOP == (stage)) { hipLaunchKernelGGL(k_dump_bf16, dim3(2048), dim3(256), 0, stream, (const bf16_t*)(ws + (off)), (size_t)(n), out); return; } } while (0)
#define DUMP_F32(stage, off, n) do { if (DBG_STOP == (stage)) { hipLaunchKernelGGL(k_dump_f32, dim3(2048), dim3(256), 0, stream, (const float*)(ws + (off)), (size_t)(n), out); return; } } while (0)
constexpr int LDS_BYTES = 163840;
template <class Epi> static void launch_gemm(const pg8::Gemm& g, const Epi& E, int grid, hipStream_t s) {
    static bool once = false; if (!once) { (void)hipFuncSetAttribute((const void*)k_gemm<Epi>, hipFuncAttributeMaxDynamicSharedMemorySize, LDS_BYTES); once = true; }
    hipLaunchKernelGGL(k_gemm<Epi>, dim3(grid), dim3(512), LDS_BYTES, s, g, E);
}

extern "C" void kernel_launch(void* const* d_in, const int* in_sizes, int n_in, void* d_out, int out_size, void* d_ws, size_t ws_size, hipStream_t stream) {
    static int grid = 0;
    if (grid == 0) { int dev = 0, cus = 0; (void)hipGetDevice(&dev); (void)hipDeviceGetAttribute(&cus, hipDeviceAttributeMultiprocessorCount, dev); grid = cus > 0 ? cus : 256;
        (void)hipFuncSetAttribute((const void*)k_prep, hipFuncAttributeMaxDynamicSharedMemorySize, LDS_BYTES);
        (void)hipFuncSetAttribute((const void*)k_gemm_pair, hipFuncAttributeMaxDynamicSharedMemorySize, LDS_BYTES);
        (void)hipFuncSetAttribute((const void*)k_hgrn_fast, hipFuncAttributeMaxDynamicSharedMemorySize, LDS_BYTES); (void)hipFuncSetAttribute((const void*)k_s5_fast, hipFuncAttributeMaxDynamicSharedMemorySize, LDS_BYTES); (void)hipFuncSetAttribute((const void*)k_s5_tab, hipFuncAttributeMaxDynamicSharedMemorySize, LDS_BYTES);
        if (ws_size < 512 * MiB) fprintf(stderr, "kernel_launch: workspace %zu < 512 MiB\n", ws_size); }
#if USE_MEGA
    { static int mgrid = 0;
      if (mgrid == 0) { int per_cu = 0; (void)hipFuncSetAttribute((const void*)k_mega, hipFuncAttributeMaxDynamicSharedMemorySize, LDS_BYTES);
          (void)hipOccupancyMaxActiveBlocksPerMultiprocessor(&per_cu, (const void*)k_mega, 512, LDS_BYTES); if (per_cu < 1) per_cu = 1; mgrid = grid * per_cu; if (mgrid > 256) mgrid = 256;
          fprintf(stderr, "k_mega: cus %d per_cu %d grid %d\n", grid, per_cu, mgrid); }
      (void)hipMemsetAsync((unsigned char*)d_ws + WS_CTL, 0, 1 * MiB, stream);
      MegaArgs a{}; for (int i = 0; i < 24; ++i) a.in[i] = (const float*)d_in[i]; a.out = (float*)d_out; a.ws = (unsigned char*)d_ws;
      void* args[] = {&a};
      hipError_t e = hipLaunchCooperativeKernel((const void*)k_mega, dim3(mgrid), dim3(512), args, LDS_BYTES, stream);
      if (e != hipSuccess) fprintf(stderr, "cooperative launch failed: %s (grid %d)\n", hipGetErrorString(e), mgrid);
      return; }
#endif
    const float* const* in = (const float* const*)d_in;
    const float *x = in[0], *ln_mix_g = in[1], *w_in = in[2], *a_re = in[3], *a_im = in[4], *log_dt = in[5], *b_re = in[6], *b_im = in[7], *c_re = in[8], *c_im = in[9], *s5d = in[10], *w_glu = in[11], *b_glu = in[12],
                *w_ps5 = in[13], *lb_logits = in[14], *norm_g = in[15], *w_ph = in[16], *w_out = in[17], *ln_ffn_g = in[18], *w_up = in[19], *conv_w = in[20], *conv_b = in[21], *w_down = in[22], *ln_final_g = in[23];
    unsigned char* ws = (unsigned char*)d_ws; float* out = (float*)d_out;
    (void)hipMemsetAsync(ws + WS_CTL, 0, 1 * MiB, stream);
    float* SSQ2 = (float*)(ws + CTL_SSQ2); float* SSQ3 = (float*)(ws + CTL_SSQ3);
#ifdef DBG_GS5WS
    bf16_t* GS5 = (bf16_t*)(ws + WS_ORAW_NAIVE); bf16_t* GH = (bf16_t*)d_out + (size_t)T_ * D_;
#else
    bf16_t* GS5 = (bf16_t*)d_out; bf16_t* GH = GS5 + (size_t)T_ * D_;
#endif
    { PrepArgs a{}; a.x = x; a.ln_mix_g = ln_mix_g; a.w_in = w_in; a.w_glu = w_glu; a.w_ps5 = w_ps5; a.w_ph = w_ph; a.w_out = w_out; a.ln_ffn_g = ln_ffn_g; a.w_up = w_up; a.w_down = w_down; a.lb_logits = lb_logits; a.ws = ws;
      hipLaunchKernelGGL(k_prep, dim3(grid), dim3(512), LDS_BYTES, stream, a); }
    DUMP_BF16(13, WS_WIN, (size_t)NIN * D_);
#if USE_FUSED_CUMSUM
    { EpiProjF E{}; E.rstd = (const float*)(ws + WS_RSTD1); E.lb = (const float*)(ws + WS_LB); E.UG = (bf16_t*)(ws + WS_UG); E.QD = (bf16_t*)(ws + WS_QD); E.KD = (bf16_t*)(ws + WS_KD); E.V = (bf16_t*)(ws + WS_V);
      E.G = (bf16_t*)(ws + WS_G); E.GS5 = GS5; E.GH = GH; E.EGL = (float*)(ws + WS_EGL);
      launch_gemm(mk_gemm(ws + WS_XB, ws + WS_WIN, T_, NIN, D_), E, grid, stream); }
#else
    { EpiProj E{}; E.rstd = (const float*)(ws + WS_RSTD1); E.lb = (const float*)(ws + WS_LB); E.UG = (bf16_t*)(ws + WS_UG); E.SQ = (bf16_t*)(ws + WS_SQ); E.KKR = (bf16_t*)(ws + WS_KKR); E.V = (bf16_t*)(ws + WS_V);
      E.G = (bf16_t*)(ws + WS_G); E.GS5 = GS5; E.GH = GH; E.LOGF = (float*)(ws + WS_LOGF);
      launch_gemm(mk_gemm(ws + WS_XB, ws + WS_WIN, T_, NIN, D_), E, grid, stream); }
#endif
    DUMP_BF16(12, WS_ORAW_NAIVE, (size_t)T_ * D_);
    DUMP_BF16(1, WS_SQ, (size_t)T_ * HW); DUMP_BF16(2, WS_UG, (size_t)T_ * W5); DUMP_F32(3, WS_LOGF, (size_t)T_ * HW);
#if USE_FAST_S5
    { S5In in{}; in.a_re = a_re; in.a_im = a_im; in.log_dt = log_dt; in.b_re = b_re; in.b_im = b_im; in.c_re = c_re; in.c_im = c_im; in.d = s5d; hipLaunchKernelGGL(k_s5_tab, dim3(64), dim3(512), LDS_BYTES, stream, in, ws + WS_S5TAB);
      S5FArgs a{}; a.UG = (const bf16_t*)(ws + WS_UG); a.tabs = ws + WS_S5TAB; a.Z = (bf16_t*)(ws + WS_Z); hipLaunchKernelGGL(k_s5_fast, dim3(256), dim3(512), LDS_BYTES, stream, a); }
#else
    { S5Args a{}; a.UG = (const bf16_t*)(ws + WS_UG); a.a_re = a_re; a.a_im = a_im; a.log_dt = log_dt; a.b_re = b_re; a.b_im = b_im; a.c_re = c_re; a.c_im = c_im; a.d = s5d; a.Z = (bf16_t*)(ws + WS_Z);
      hipLaunchKernelGGL(k_s5_naive, dim3(256), dim3(64), 0, stream, a); }
#endif
#if USE_FAST_HGRN
#if !USE_FUSED_CUMSUM
    hipLaunchKernelGGL(k_cumsum, dim3(HW / 256, T_ / 64), dim3(256), 0, stream, (const bf16_t*)(ws + WS_SQ), (const float*)(ws + WS_LOGF), (const bf16_t*)(ws + WS_KKR), (bf16_t*)(ws + WS_QD), (bf16_t*)(ws + WS_KD), (float*)(ws + WS_EGL));
#endif
    { HgrnArgs a{}; a.QD = (const bf16_t*)(ws + WS_QD); a.KD = (const bf16_t*)(ws + WS_KD); a.EGL = (const float*)(ws + WS_EGL); a.V = (const bf16_t*)(ws + WS_V); a.ORAW = (bf16_t*)(ws + WS_ORAW); a.SSQH = (float*)(ws + WS_SSQH);
      hipLaunchKernelGGL(k_hgrn_fast, dim3(128), dim3(512), LDS_BYTES, stream, a); }
    hipLaunchKernelGGL(k_oh_fast, dim3(grid), dim3(512), 0, stream, (const bf16_t*)(ws + WS_ORAW), (const float*)(ws + WS_SSQH), (const bf16_t*)(ws + WS_G), norm_g, (bf16_t*)(ws + WS_OH));
#else
    hipLaunchKernelGGL(k_hgrn_naive, dim3(32), dim3(128), 0, stream, (const bf16_t*)(ws + WS_SQ), (const float*)(ws + WS_LOGF), (const bf16_t*)(ws + WS_KKR), (const bf16_t*)(ws + WS_V), (float*)(ws + WS_ORAW_NAIVE));
    hipLaunchKernelGGL(k_oh_naive, dim3(T_ * 8), dim3(64), 0, stream, (const float*)(ws + WS_ORAW_NAIVE), (const bf16_t*)(ws + WS_G), norm_g, (bf16_t*)(ws + WS_OH));
#endif
    if (DBG_STOP == 10) { (void)hipMemcpyAsync(ws + WS_MERGED, GH, (size_t)T_ * D_ * 2, hipMemcpyDeviceToDevice, stream); DUMP_BF16(10, WS_MERGED, (size_t)T_ * D_); }
    if (DBG_STOP == 11) { (void)hipMemcpyAsync(ws + WS_MERGED, GS5, (size_t)T_ * D_ * 2, hipMemcpyDeviceToDevice, stream); DUMP_BF16(11, WS_MERGED, (size_t)T_ * D_); }
    DUMP_BF16(4, WS_Z, (size_t)T_ * W5); DUMP_BF16(5, WS_OH, (size_t)T_ * HW);
    { EpiGlu E{}; E.Z = (const bf16_t*)(ws + WS_Z); E.bias = b_glu; E.ZS = (bf16_t*)(ws + WS_ZS); launch_gemm(mk_gemm(ws + WS_Z, ws + WS_WGLU, T_, W5, W5), E, grid, stream); }
    DUMP_BF16(6, WS_ZS, (size_t)T_ * W5);
    { EpiMerged E{}; E.GS5 = GS5; E.GH = GH; E.MERGED = (bf16_t*)(ws + WS_MERGED);
      pg8::Gemm g = mk_gemm(ws + WS_ZS, ws + WS_WPS5, T_, D_, W5); g.A2 = (const bf16_t*)(ws + WS_OH); g.Bt2 = (const bf16_t*)(ws + WS_WPH);
      hipLaunchKernelGGL(k_gemm_pair, dim3(grid), dim3(512), LDS_BYTES, stream, g, E); }
    DUMP_BF16(7, WS_MERGED, (size_t)T_ * D_);
    { EpiRes E{}; E.XI = x; E.XO = out; E.XBF = (bf16_t*)(ws + WS_X1B); E.ssq = SSQ2; launch_gemm(mk_gemm(ws + WS_MERGED, ws + WS_WOUT, T_, D_, D_), E, grid, stream); }
    if (DBG_STOP == 8) return;
#if USE_FUSED_CONV
    { EpiUpConv E{}; E.ssq = SSQ2; E.cw = conv_w; E.cb = conv_b; E.ACT = (bf16_t*)(ws + WS_ACT); E.RAW = (bf16_t*)(ws + WS_RAW); launch_gemm(mk_gemm(ws + WS_X1B, ws + WS_WUP, T_, NUP, D_), E, grid, stream);
      hipLaunchKernelGGL(k_conv_fixup, dim3(grid), dim3(512), 0, stream, (const bf16_t*)(ws + WS_RAW), conv_w, conv_b, (bf16_t*)(ws + WS_ACT)); }
#else
    for (int q = 0; q < 4; ++q) {
        EpiUpNaive E{}; E.ssq = SSQ2; E.UP = (bf16_t*)(ws + WS_UPQ); E.row0 = q * L_;
        launch_gemm(mk_gemm((bf16_t*)(ws + WS_X1B) + (size_t)q * L_ * D_, ws + WS_WUP, L_, NUP, D_), E, grid, stream);
        hipLaunchKernelGGL(k_conv_naive, dim3(FF / 256, L_), dim3(256), 0, stream, (const bf16_t*)(ws + WS_UPQ), conv_w, conv_b, (bf16_t*)(ws + WS_ACT), q * L_);
    }
    DUMP_BF16(9, WS_ACT, (size_t)T_ * FF);
#endif
    { EpiRes E{}; E.XI = out; E.XO = out; E.XBF = nullptr; E.ssq = SSQ3; launch_gemm(mk_gemm(ws + WS_ACT, ws + WS_WDOWN, T_, D_, FF), E, grid, stream); }
    hipLaunchKernelGGL(k_final, dim3(T_), dim3(256), 0, stream, out, (const float*)SSQ3, ln_final_g);
}
```

```cpp
#include <hip/hip_runtime.h>
#include <hip/hip_cooperative_groups.h>
namespace cg = cooperative_groups;
#include <cstdio>
#include <cstdint>
namespace pg8 {
#define PG8_LAS __attribute__((address_space(3)))
typedef unsigned short bf16_t;
typedef short bf16x8 __attribute__((ext_vector_type(8)));
typedef float f32x4 __attribute__((ext_vector_type(4)));
typedef unsigned u32x4 __attribute__((ext_vector_type(4)));
constexpr int BM = 256, BK = 64, HALF = 128, HTB = HALF * BK * 2  , STAGE_BYTES = 8 * HTB, NXCD = 8, WGM = 8;

__host__ __device__ __forceinline__ int lds_byte(int r, int c) { const int st = (r >> 4) * 2 + (c >> 5), rr = r & 15, cc = c & 31, ob = rr * 64 + cc * 2; return st * 1024 + (ob ^ (((ob >> 9) & 1) << 5)); }
__host__ __device__ __forceinline__ void stage_rc(int b, int& R, int& C) { const int st = b / 1024, sb = b % 1024, swz = sb ^ (((sb >> 9) & 1) << 5); R = (st >> 1) * 16 + swz / 64; C = (st & 1) * 32 + (swz % 64) / 2; }
__host__ __device__ __forceinline__ int perm32(int rho) { const int n = rho >> 4, i = rho & 15; return 8 * (i >> 2) + 4 * n + (i & 3); }

struct Unit { int pm, pn, seg; };
struct Gemm { const bf16_t* A; const bf16_t* Bt; const bf16_t* A2; const bf16_t* Bt2; int M, N, K, pad; };

struct StaticOrder {
    int nM, nN, nwg, G, c;
    __host__ __device__ void init(int M, int N, int G_, int c_) { nM = M / BM; nN = N / BM; nwg = nM * nN; G = G_; c = c_; }
    __host__ __device__ bool next(int i, Unit& u) const {
        const long L = (long)i * G + c; if (L >= nwg) return false;
        int wgid = (int)L; { const int q = nwg / NXCD, r = nwg % NXCD, xcd = wgid % NXCD, off = wgid / NXCD; wgid = (xcd < r ? xcd * (q + 1) : r * (q + 1) + (xcd - r) * q) + off; }
        const int nig = WGM * nN, gid = wgid / nig, fm = gid * WGM, gsz = (nM - fm) < WGM ? (nM - fm) : WGM;
        u.pm = fm + ((wgid % nig) % gsz); u.pn = (wgid % nig) / gsz; u.seg = 0; return true;
    }
    __device__ __forceinline__ void a_ready(const Unit&) const {}
    __device__ __forceinline__ void done(const Unit&) const {}
};
struct RangeOrder { int first, count, pn0;
    __host__ __device__ bool next(int i, Unit& u) const { if (i >= count) return false; const int id = first + i; u.pm = id >> 4; u.pn = pn0 + (id & 15); u.seg = 0; return true; }
    __device__ __forceinline__ void a_ready(const Unit&) const {}
    __device__ __forceinline__ void done(const Unit&) const {}
};
struct PanelOrder { int c;
    __host__ __device__ bool next(int i, Unit& u) const { if (i >= 2) return false; const int x = c & 7, k = c >> 3; u.pn = k & 7; u.pm = 8 * x + (k >> 3) + 4 * i; u.seg = 0; return true; }
    __device__ __forceinline__ void a_ready(const Unit&) const {}
    __device__ __forceinline__ void done(const Unit&) const {}
};
struct PairOrder : StaticOrder { __host__ __device__ bool next(int i, Unit& u) const { if (!StaticOrder::next(i >> 1, u)) return false; u.seg = i & 1; return true; } };

typedef float f32x2_cv __attribute__((ext_vector_type(2))); typedef __bf16 bf16x2_cv __attribute__((ext_vector_type(2)));
__device__ __forceinline__ unsigned cvt_pk_bf16(float lo, float hi) { f32x2_cv v = {lo, hi}; bf16x2_cv b = __builtin_convertvector(v, bf16x2_cv); return __builtin_bit_cast(unsigned, b); }
template <class Epi, class Sched, bool ALIGN_EPI = false, bool SP2 = false>
__device__ __forceinline__ void gemm_phase(PG8_LAS unsigned char* lds, const Gemm g, const Sched& S, const Epi& E) {
    int tid_ = threadIdx.x; asm volatile("" : "+v"(tid_));
    const int tid = tid_, wid = __builtin_amdgcn_readfirstlane(tid >> 6), lane = tid & 63, wr = wid >> 2, wc = wid & 3, fr = lane & 15, fq = lane >> 4;
    const int K = g.K, nt = K / BK;
    unsigned voffA[2], voffB[2];
#pragma unroll
    for (int i = 0; i < 2; ++i) { int R, C; stage_rc(tid * 16 + i * 8192, R, C); const int Rb = Epi::PERM ? ((R & ~31) + perm32(R & 31)) : R;
        voffA[i] = (unsigned)(R * K + C) * 2u; voffB[i] = (unsigned)(Rb * K + C) * 2u; }
    const size_t kstep = (size_t)(BK * 2);
    const size_t hstep = (size_t)HALF * K * 2;
    const size_t tstep = 2 * hstep;
    const unsigned ldsw = (unsigned)wid * 1024u;
    const int aoff = lds_byte(wr * 64 + fr, fq * 8), boff = lds_byte(wc * 32 + fr, fq * 8);
#define PG8_SA(b, h) (((b) * 2 + (h)) * HTB)
#define PG8_SB(b, h) ((4 + (b) * 2 + (h)) * HTB)
#define PG8_STAGE(bufoff, gbase, voff) do { _Pragma("unroll") for (int _i = 0; _i < 2; ++_i) \
        __builtin_amdgcn_global_load_lds((const unsigned*)((const char*)(gbase) + (voff)[_i]), (PG8_LAS unsigned*)(lds + (bufoff) + ldsw + _i * 8192), 16, 0, 0); } while (0)
#define PG8_LDA(dst, b, h) do { _Pragma("unroll") for (int m = 0; m < 4; ++m) _Pragma("unroll") for (int k = 0; k < 2; ++k) dst[m][k] = *(const PG8_LAS bf16x8*)(lds + PG8_SA(b, h) + aoff + m * 2048 + k * 1024); } while (0)
#define PG8_LDB(dst, b, h) do { _Pragma("unroll") for (int n = 0; n < 2; ++n) _Pragma("unroll") for (int k = 0; k < 2; ++k) dst[n][k] = *(const PG8_LAS bf16x8*)(lds + PG8_SB(b, h) + boff + n * 2048 + k * 1024); } while (0)
#define PG8_MMA(ai, bj, At, Bt) do { __builtin_amdgcn_s_setprio(1); _Pragma("unroll") for (int m = 0; m < 4; ++m) _Pragma("unroll") for (int n = 0; n < 2; ++n) _Pragma("unroll") for (int k = 0; k < 2; ++k) \
        acc[ai][bj][m][n] = __builtin_amdgcn_mfma_f32_16x16x32_bf16(Bt[n][k], At[m][k], acc[ai][bj][m][n], 0, 0, 0); __builtin_amdgcn_s_setprio(0); } while (0)
#define PG8_WAIT_V(n) asm volatile("s_waitcnt vmcnt(" #n ")" ::: "memory")
#define PG8_WAIT_L(n) asm volatile("s_waitcnt lgkmcnt(" #n ")" ::: "memory")
#define PG8_BAR __builtin_amdgcn_s_barrier()
#define PG8_SCHED __builtin_amdgcn_sched_barrier(0)
    Unit cur, nxt; int ui = 0;
    if (!S.next(0, cur)) return;
    f32x4 acc[2][2][4][2];
#pragma unroll
    for (int a = 0; a < 2; ++a)
#pragma unroll
        for (int b = 0; b < 2; ++b)
#pragma unroll
            for (int m = 0; m < 4; ++m)
#pragma unroll
                for (int n = 0; n < 2; ++n) acc[a][b][m][n] = (f32x4){0.f, 0.f, 0.f, 0.f};
    bf16x8 At[4][2], B0[2][2], B1[2][2];
    const char* cA = (const char*)(cur.seg ? g.A2 : g.A) + (size_t)cur.pm * tstep; const char* cB = (const char*)(cur.seg ? g.Bt2 : g.Bt) + (size_t)cur.pn * tstep;
    S.a_ready(cur);
    if constexpr (SP2) {
        PG8_STAGE(PG8_SB(0, 0), cB, voffB); PG8_STAGE(PG8_SB(0, 1), cB + hstep, voffB); PG8_STAGE(PG8_SA(0, 0), cA, voffA); PG8_STAGE(PG8_SA(0, 1), cA + hstep, voffA);
        if (wr == 1) PG8_BAR;
        PG8_WAIT_V(2); PG8_BAR;
        PG8_STAGE(PG8_SB(1, 0), cB + kstep, voffB); PG8_STAGE(PG8_SA(1, 0), cA + kstep, voffA); PG8_STAGE(PG8_SB(1, 1), cB + hstep + kstep, voffB);
        PG8_WAIT_V(6); PG8_BAR;
    } else {
        PG8_STAGE(PG8_SB(0, 0), cB, voffB); PG8_STAGE(PG8_SA(0, 0), cA, voffA); PG8_STAGE(PG8_SB(0, 1), cB + hstep, voffB); PG8_STAGE(PG8_SA(0, 1), cA + hstep, voffA);
        if (wr == 1) PG8_BAR;
        PG8_WAIT_V(4); PG8_BAR;
        PG8_STAGE(PG8_SB(1, 0), cB + kstep, voffB); PG8_STAGE(PG8_SA(1, 0), cA + kstep, voffA); PG8_STAGE(PG8_SB(1, 1), cB + hstep + kstep, voffB);
        PG8_WAIT_V(6); PG8_BAR;
    }
    for (;;) {
        const bool has_next = S.next(ui + 1, nxt);
        const char* nA = has_next ? (const char*)(nxt.seg ? g.A2 : g.A) + (size_t)nxt.pm * tstep : cA; const char* nB = has_next ? (const char*)(nxt.seg ? g.Bt2 : g.Bt) + (size_t)nxt.pn * tstep : cB;
        for (int t = 0; t < nt; t += 2) {
            const bool last = (t == nt - 2);
            const char* a1 = cA + (size_t)(t + 1) * kstep;
            const char* a2 = last ? nA : cA + (size_t)(t + 2) * kstep; const char* b2 = last ? nB : cB + (size_t)(t + 2) * kstep;
            const char* a3 = a2 + kstep; const char* b3 = b2 + kstep;
            if (last && has_next) S.a_ready(nxt);
            if constexpr (SP2) {
            PG8_LDB(B0, 0, 0); PG8_LDB(B1, 0, 1); PG8_SCHED; PG8_LDA(At, 0, 0); PG8_STAGE(PG8_SA(1, 1), a1 + hstep, voffA);
            PG8_WAIT_V(8); PG8_WAIT_L(0); PG8_BAR; PG8_MMA(0, 0, At, B0); PG8_MMA(0, 1, At, B1); PG8_BAR; PG8_SCHED;
            PG8_LDA(At, 0, 1); PG8_STAGE(PG8_SB(0, 0), b2, voffB); PG8_STAGE(PG8_SB(0, 1), b2 + hstep, voffB); PG8_STAGE(PG8_SA(0, 0), a2, voffA);
            PG8_WAIT_V(8); PG8_WAIT_L(0); PG8_BAR; PG8_MMA(1, 0, At, B0); PG8_MMA(1, 1, At, B1); PG8_BAR; PG8_SCHED;
            PG8_LDB(B0, 1, 0); PG8_LDB(B1, 1, 1); PG8_SCHED; PG8_LDA(At, 1, 0); PG8_STAGE(PG8_SA(0, 1), a2 + hstep, voffA);
            PG8_WAIT_V(8); PG8_WAIT_L(0); PG8_BAR; PG8_MMA(0, 0, At, B0); PG8_MMA(0, 1, At, B1); PG8_BAR; PG8_SCHED;
            PG8_LDA(At, 1, 1); PG8_STAGE(PG8_SB(1, 0), b3, voffB); PG8_STAGE(PG8_SB(1, 1), b3 + hstep, voffB); PG8_STAGE(PG8_SA(1, 0), a3, voffA);
            PG8_WAIT_V(8); PG8_WAIT_L(0); PG8_BAR; PG8_MMA(1, 0, At, B0); PG8_MMA(1, 1, At, B1); PG8_BAR; PG8_SCHED;
            } else {
            PG8_LDB(B0, 0, 0); PG8_SCHED; PG8_LDA(At, 0, 0); PG8_STAGE(PG8_SA(1, 1), a1 + hstep, voffA);
            PG8_WAIT_L(8); PG8_BAR; PG8_WAIT_L(0); PG8_MMA(0, 0, At, B0); PG8_BAR; PG8_SCHED;
            PG8_LDB(B1, 0, 1); PG8_STAGE(PG8_SB(0, 0), b2, voffB);
            PG8_BAR; PG8_WAIT_L(0); PG8_MMA(0, 1, At, B1); PG8_BAR;
            PG8_LDA(At, 0, 1); PG8_STAGE(PG8_SA(0, 0), a2, voffA);
            PG8_BAR; PG8_WAIT_L(0); PG8_MMA(1, 0, At, B0); PG8_BAR; PG8_SCHED;
            PG8_STAGE(PG8_SB(0, 1), b2 + hstep, voffB);
            PG8_WAIT_V(6); PG8_BAR; PG8_MMA(1, 1, At, B1); PG8_BAR;
            PG8_LDB(B0, 1, 0); PG8_SCHED; PG8_LDA(At, 1, 0); PG8_STAGE(PG8_SA(0, 1), a2 + hstep, voffA);
            PG8_WAIT_L(8); PG8_BAR; PG8_WAIT_L(0); PG8_MMA(0, 0, At, B0); PG8_BAR; PG8_SCHED;
            PG8_LDB(B1, 1, 1); PG8_STAGE(PG8_SB(1, 0), b3, voffB);
            PG8_BAR; PG8_WAIT_L(0); PG8_MMA(0, 1, At, B1); PG8_BAR;
            PG8_LDA(At, 1, 1); PG8_STAGE(PG8_SA(1, 0), a3, voffA);
            PG8_BAR; PG8_WAIT_L(0); PG8_MMA(1, 0, At, B0); PG8_BAR; PG8_SCHED;
            PG8_STAGE(PG8_SB(1, 1), b3 + hstep, voffB);
            PG8_WAIT_V(6); PG8_BAR; PG8_MMA(1, 1, At, B1); PG8_BAR;
            }
        }
        if constexpr (ALIGN_EPI) { if (wr == 0) PG8_BAR; }
        bool keep = false;
        if constexpr (Epi::MID) keep = (cur.seg == 0);
        if constexpr (!Epi::AFTER_DRAIN) { if (keep) { if constexpr (Epi::MID) E.mid(acc, cur, wr, wc, fr, fq); } else E(acc, cur, wr, wc, fr, fq); S.done(cur); }
        if (!has_next) break;
        if (!keep) {
#pragma unroll
        for (int a = 0; a < 2; ++a)
#pragma unroll
            for (int b = 0; b < 2; ++b)
#pragma unroll
                for (int m = 0; m < 4; ++m)
#pragma unroll
                    for (int n = 0; n < 2; ++n) acc[a][b][m][n] = (f32x4){0.f, 0.f, 0.f, 0.f};
        }
        cur = nxt; cA = nA; cB = nB; ++ui;
        if constexpr (ALIGN_EPI) { if (wr == 1) PG8_BAR; }
    }
    PG8_WAIT_V(0);
    if constexpr (!ALIGN_EPI) { if (wr == 0) PG8_BAR; }
    PG8_BAR;
    if constexpr (Epi::AFTER_DRAIN) { E.fused(acc, cur, wr, wc, fr, fq, lds, wid, lane); S.done(cur); }
#undef PG8_SA
#undef PG8_SB
#undef PG8_STAGE
#undef PG8_LDA
#undef PG8_LDB
#undef PG8_MMA
#undef PG8_WAIT_V
#undef PG8_WAIT_L
#undef PG8_BAR
#undef PG8_SCHED
}
}

typedef pg8::bf16_t bf16_t;
typedef pg8::f32x4 f32x4;
typedef pg8::u32x4 u32x4;
typedef unsigned u32x2 __attribute__((ext_vector_type(2)));
typedef pg8::Unit Unit;
#define LAS __attribute__((address_space(3)))

constexpr int T_ = 16384, D_ = 2048, L_ = 4096, NIN = 9216, W5 = 1024, HW = 1024, FF = 5632, NUP = 11264;
constexpr float RMS_EPS = 1e-6f;
constexpr size_t MiB = (size_t)1 << 20;
constexpr size_t WS_CTL = 0;
constexpr size_t CTL_SSQ2 = 256 * 1024, CTL_SSQ3 = 384 * 1024, CTL_CNT7 = 512 * 1024  ;
constexpr size_t WS_S5TAB = 1 * MiB;
constexpr size_t WS_RSTD1 = 12 * MiB, WS_LB = 12 * MiB + 192 * 1024, WS_EGL = 13 * MiB;
constexpr size_t WS_WGLU = 16 * MiB, WS_WPS5 = 500 * MiB, WS_WPH = 504 * MiB, WS_WOUT = 492 * MiB, WS_WDOWN = 34 * MiB, WS_WUP = 56 * MiB, WS_WIN = 392 * MiB;
constexpr size_t WS_XB2 = 428 * MiB;
#ifndef X_BF16_RESID
#define X_BF16_RESID 1
#endif
constexpr size_t WS_XB = 428 * MiB, WS_UG = 200 * MiB, WS_QD = 232 * MiB, WS_KD = 264 * MiB, WS_V = 296 * MiB, WS_G = 328 * MiB;
constexpr size_t WS_LOGF = 360 * MiB, WS_SQ = 424 * MiB, WS_KKR = 456 * MiB;
constexpr size_t WS_Z = 360 * MiB  , WS_ZS = 296 * MiB  , WS_OH = 200 * MiB, WS_ORAW = 136 * MiB, WS_ORAW_NAIVE = 232 * MiB, WS_SSQH = 508 * MiB;
constexpr size_t WS_MERGED = 232 * MiB, WS_X1B = 296 * MiB, WS_ACT = 100 * MiB, WS_RAW = 360 * MiB, WS_UPQ = 360 * MiB  ;

__device__ __forceinline__ float bf2f(unsigned short b) { return __uint_as_float(((unsigned)b) << 16); }
__device__ __forceinline__ float sigmoid_f(float x) { return __builtin_amdgcn_rcpf(1.0f + __expf(-x)); }
__device__ __forceinline__ float silu_f(float x) { return x * sigmoid_f(x); }
__device__ __forceinline__ float gelu_tanh_f(float x) { const float a = 1.5957691216057308f * (x + 0.044715f * x * x * x); return x * sigmoid_f(a); }
__device__ __forceinline__ u32x4 pack8(const float* v) { u32x4 w; w.x = pg8::cvt_pk_bf16(v[0], v[1]); w.y = pg8::cvt_pk_bf16(v[2], v[3]); w.z = pg8::cvt_pk_bf16(v[4], v[5]); w.w = pg8::cvt_pk_bf16(v[6], v[7]); return w; }
__device__ __forceinline__ void unpack8(const u32x4 w, float* v) { v[0] = __uint_as_float(w.x << 16); v[1] = __uint_as_float(w.x & 0xffff0000u); v[2] = __uint_as_float(w.y << 16); v[3] = __uint_as_float(w.y & 0xffff0000u);
    v[4] = __uint_as_float(w.z << 16); v[5] = __uint_as_float(w.z & 0xffff0000u); v[6] = __uint_as_float(w.w << 16); v[7] = __uint_as_float(w.w & 0xffff0000u); }
#define ACC8(v, a, sc) do { v[0] = a[0][0] * (sc); v[1] = a[0][1] * (sc); v[2] = a[0][2] * (sc); v[3] = a[0][3] * (sc); v[4] = a[1][0] * (sc); v[5] = a[1][1] * (sc); v[6] = a[1][2] * (sc); v[7] = a[1][3] * (sc); } while (0)

struct EpiProj {
    static constexpr bool PERM = true, AFTER_DRAIN = false, MID = false;
    const float* rstd; const float* lb; bf16_t *UG, *SQ, *KKR, *V, *G, *GS5, *GH; float* LOGF;
    __device__ __forceinline__ void operator()(const f32x4 (&acc)[2][2][4][2], const Unit& u, int wr, int wc, int fr, int fq) const {
        const int rowb = u.pm * 256 + wr * 64 + fr, cb = wc * 32 + 8 * fq, pn = u.pn;
#pragma unroll
        for (int ai = 0; ai < 2; ++ai)
#pragma unroll
            for (int m = 0; m < 4; ++m) {
                const int row = rowb + ai * 128 + m * 16; const float s = rstd[row];
#pragma unroll
                for (int bj = 0; bj < 2; ++bj) {
                    float v[8]; ACC8(v, acc[ai][bj][m], s);
                    if (pn < 4) { const int col = pn * 256 + bj * 128 + cb, g = col >> 4, c = col & 15, b = row >> 12, t = row & 4095;
                        *(u32x4*)(UG + (((size_t)(b * 64 + g) * L_ + t) * 16 + c)) = pack8(v); }
                    else if (pn < 12) { const int ch = (pn - 4) * 128 + cb;
                        if (bj == 0) { float o[8];
#pragma unroll
                            for (int j = 0; j < 8; ++j) o[j] = silu_f(v[j]);
                            *(u32x4*)(SQ + (size_t)row * HW + ch) = pack8(o); }
                        else { float lf[8], kk[8]; const f32x4 l0 = *(const f32x4*)(lb + ch), l1 = *(const f32x4*)(lb + ch + 4);
#pragma unroll
                            for (int j = 0; j < 8; ++j) { const float lbv = j < 4 ? l0[j] : l1[j - 4]; const float sg = sigmoid_f(v[j]); lf[j] = __logf(lbv + (1.0f - lbv) * sg); kk[j] = (1.0f - lbv) * sigmoid_f(-v[j]); }
                            *(f32x4*)(LOGF + (size_t)row * HW + ch) = (f32x4){lf[0], lf[1], lf[2], lf[3]}; *(f32x4*)(LOGF + (size_t)row * HW + ch + 4) = (f32x4){lf[4], lf[5], lf[6], lf[7]};
                            *(u32x4*)(KKR + (size_t)row * HW + ch) = pack8(kk); } }
                    else if (pn < 16) { const int col = (pn - 12) * 256 + bj * 128 + cb; *(u32x4*)(V + (size_t)row * HW + col) = pack8(v); }
                    else if (pn < 20) { const int col = (pn - 16) * 256 + bj * 128 + cb; float o[8];
#pragma unroll
                        for (int j = 0; j < 8; ++j) o[j] = silu_f(v[j]);
                        *(u32x4*)(G + (size_t)row * HW + col) = pack8(o); }
                    else { const int col = ((pn - 20) & 7) * 256 + bj * 128 + cb; float o[8];
#pragma unroll
                        for (int j = 0; j < 8; ++j) o[j] = sigmoid_f(v[j]);
                        *(u32x4*)((pn < 28 ? GS5 : GH) + (size_t)row * D_ + col) = pack8(o); }
                }
            }
    }
};
struct EpiGlu {
    static constexpr bool PERM = true, AFTER_DRAIN = false, MID = false;
    const bf16_t* Z; const float* bias; bf16_t* ZS;
    __device__ __forceinline__ void operator()(const f32x4 (&acc)[2][2][4][2], const Unit& u, int wr, int wc, int fr, int fq) const {
        const int rowb = u.pm * 256 + wr * 64 + fr, colb = u.pn * 256 + wc * 32 + 8 * fq;
#pragma unroll
        for (int ai = 0; ai < 2; ++ai)
#pragma unroll
            for (int m = 0; m < 4; ++m) { const int row = rowb + ai * 128 + m * 16;
#pragma unroll
                for (int bj = 0; bj < 2; ++bj) { const int col = colb + bj * 128; float v[8], z[8], o[8]; ACC8(v, acc[ai][bj][m], 1.0f);
                    unpack8(*(const u32x4*)(Z + (size_t)row * W5 + col), z); const f32x4 b0 = *(const f32x4*)(bias + col), b1 = *(const f32x4*)(bias + col + 4);
#pragma unroll
                    for (int j = 0; j < 8; ++j) o[j] = z[j] * sigmoid_f(v[j] + (j < 4 ? b0[j] : b1[j - 4]));
                    *(u32x4*)(ZS + (size_t)row * W5 + col) = pack8(o); } }
    }
};
struct EpiMerged {
    static constexpr bool PERM = true, AFTER_DRAIN = false, MID = true;
    const bf16_t* GS5; const bf16_t* GH; bf16_t* MERGED;
    __device__ __forceinline__ void mid(f32x4 (&acc)[2][2][4][2], const Unit& u, int wr, int wc, int fr, int fq) const {
        const int rowb = u.pm * 256 + wr * 64 + fr, colb = u.pn * 256 + wc * 32 + 8 * fq;
#pragma unroll
        for (int ai = 0; ai < 2; ++ai)
#pragma unroll
            for (int m = 0; m < 4; ++m) { const int row = rowb + ai * 128 + m * 16;
#pragma unroll
                for (int bj = 0; bj < 2; ++bj) { const size_t o = (size_t)row * D_ + colb + bj * 128; float a[8]; unpack8(*(const u32x4*)(GS5 + o), a);
#pragma unroll
                    for (int j = 0; j < 8; ++j) acc[ai][bj][m][j >> 2][j & 3] *= a[j]; }
                asm volatile("" ::: "memory"); }
    }
    __device__ __forceinline__ void operator()(const f32x4 (&acc)[2][2][4][2], const Unit& u, int wr, int wc, int fr, int fq) const {
        const int rowb = u.pm * 256 + wr * 64 + fr, colb = u.pn * 256 + wc * 32 + 8 * fq;
#pragma unroll
        for (int ai = 0; ai < 2; ++ai)
#pragma unroll
            for (int m = 0; m < 4; ++m) { const int row = rowb + ai * 128 + m * 16;
#pragma unroll
                for (int bj = 0; bj < 2; ++bj) { const size_t o = (size_t)row * D_ + colb + bj * 128; float v[8], b[8]; ACC8(v, acc[ai][bj][m], 1.0f); unpack8(*(const u32x4*)(GH + o), b);
#pragma unroll
                    for (int j = 0; j < 8; ++j) v[j] *= b[j];
                    *(u32x4*)(MERGED + o) = pack8(v); }
                asm volatile("" ::: "memory"); }
    }
};
struct EpiRes {
    static constexpr bool PERM = true, AFTER_DRAIN = false, MID = false;
    const float* XI; float* XO; bf16_t* XBF; float* ssq; const bf16_t* XIB;
    __device__ __forceinline__ void operator()(const f32x4 (&acc)[2][2][4][2], const Unit& u, int wr, int wc, int fr, int fq) const {
        const int rowb = u.pm * 256 + wr * 64 + fr, colb = u.pn * 256 + wc * 32 + 8 * fq;
#pragma unroll
        for (int ai = 0; ai < 2; ++ai)
#pragma unroll
            for (int m = 0; m < 4; ++m) { const int row = rowb + ai * 128 + m * 16; float sq = 0.f;
#pragma unroll
                for (int bj = 0; bj < 2; ++bj) { const size_t o = (size_t)row * D_ + colb + bj * 128; f32x4 x0, x1;
                    if (XIB) { float xv[8]; unpack8(*(const u32x4*)(XIB + o), xv); x0 = (f32x4){xv[0], xv[1], xv[2], xv[3]}; x1 = (f32x4){xv[4], xv[5], xv[6], xv[7]}; } else { x0 = *(const f32x4*)(XI + o); x1 = *(const f32x4*)(XI + o + 4); }
                    const f32x4 y0 = x0 + acc[ai][bj][m][0], y1 = x1 + acc[ai][bj][m][1];
                    if (XO) { *(f32x4*)(XO + o) = y0; *(f32x4*)(XO + o + 4) = y1; }
                    sq += (y0[0] * y0[0] + y0[1] * y0[1]) + (y0[2] * y0[2] + y0[3] * y0[3]) + (y1[0] * y1[0] + y1[1] * y1[1]) + (y1[2] * y1[2] + y1[3] * y1[3]);
                    if (XBF) { float v[8] = {y0[0], y0[1], y0[2], y0[3], y1[0], y1[1], y1[2], y1[3]}; *(u32x4*)(XBF + o) = pack8(v); } }
                sq += __shfl_xor(sq, 16); sq += __shfl_xor(sq, 32);
                if (fq == 0) atomicAdd(ssq + row, sq); }
    }
};
struct EpiResFinal {
    static constexpr bool PERM = true, AFTER_DRAIN = false, MID = false;
    float* XO; const bf16_t* X1; float* ssq; unsigned* cnt; const float* gfin; unsigned* tmo;
    __device__ __forceinline__ void operator()(const f32x4 (&acc)[2][2][4][2], const Unit& u, int wr, int wc, int fr, int fq) const {
        const int rowb = u.pm * 256 + wr * 64 + fr, colb = u.pn * 256 + wc * 32 + 8 * fq; float sink = 0.f;
        f32x4 (&y)[2][2][4][2] = const_cast<f32x4 (&)[2][2][4][2]>(acc);
#pragma unroll
        for (int ai = 0; ai < 2; ++ai)
#pragma unroll
            for (int m = 0; m < 4; ++m) { const int row = rowb + ai * 128 + m * 16; float sq = 0.f;
#pragma unroll
                for (int bj = 0; bj < 2; ++bj) { const size_t o = (size_t)row * D_ + colb + bj * 128; float xv[8]; unpack8(*(const u32x4*)(X1 + o), xv);
                    const f32x4 y0 = (f32x4){xv[0], xv[1], xv[2], xv[3]} + acc[ai][bj][m][0], y1 = (f32x4){xv[4], xv[5], xv[6], xv[7]} + acc[ai][bj][m][1]; y[ai][bj][m][0] = y0; y[ai][bj][m][1] = y1;
                    sq += (y0[0] * y0[0] + y0[1] * y0[1]) + (y0[2] * y0[2] + y0[3] * y0[3]) + (y1[0] * y1[0] + y1[1] * y1[1]) + (y1[2] * y1[2] + y1[3] * y1[3]); }
                sq += __shfl_xor(sq, 16); sq += __shfl_xor(sq, 32);
                if (fq == 0) sink += __hip_atomic_fetch_add(ssq + row, sq, __ATOMIC_RELAXED, __HIP_MEMORY_SCOPE_AGENT); }
        asm volatile("s_waitcnt vmcnt(0)" :: "v"(sink) : "memory");
        unsigned* c = cnt + 64 * u.pm;
        if (fq * 16 + fr == 0) __hip_atomic_fetch_add(c, 1u, __ATOMIC_RELAXED, __HIP_MEMORY_SCOPE_AGENT);
        { unsigned sp = 0; while ((unsigned)__builtin_amdgcn_readfirstlane(__hip_atomic_load(c, __ATOMIC_RELAXED, __HIP_MEMORY_SCOPE_AGENT)) < 64u) { __builtin_amdgcn_s_sleep(2);
              if (++sp > (1u << 22)) { if (fq * 16 + fr == 0) __hip_atomic_store(tmo, 1u, __ATOMIC_RELAXED, __HIP_MEMORY_SCOPE_AGENT); break; } } }
#pragma unroll
        for (int ai = 0; ai < 2; ++ai)
#pragma unroll
            for (int m = 0; m < 4; ++m) { const int row = rowb + ai * 128 + m * 16; const float r = rsqrtf(__hip_atomic_load(ssq + row, __ATOMIC_RELAXED, __HIP_MEMORY_SCOPE_AGENT) * (1.0f / D_) + RMS_EPS);
#pragma unroll
                for (int bj = 0; bj < 2; ++bj) { const size_t o = (size_t)row * D_ + colb + bj * 128; const f32x4 g0 = *(const f32x4*)(gfin + colb + bj * 128), g1 = *(const f32x4*)(gfin + colb + bj * 128 + 4);
                    *(f32x4*)(XO + o) = y[ai][bj][m][0] * r * g0; *(f32x4*)(XO + o + 4) = y[ai][bj][m][1] * r * g1; }
                asm volatile("" ::: "memory"); }
    }
};
struct EpiUpNaive {
    static constexpr bool PERM = true, AFTER_DRAIN = false, MID = false;
    const float* ssq; bf16_t* UP; int row0, pad;
    __device__ __forceinline__ void operator()(const f32x4 (&acc)[2][2][4][2], const Unit& u, int wr, int wc, int fr, int fq) const {
        const int rowb = u.pm * 256 + wr * 64 + fr, colb = u.pn * 256 + wc * 32 + 8 * fq;
#pragma unroll
        for (int ai = 0; ai < 2; ++ai)
#pragma unroll
            for (int m = 0; m < 4; ++m) { const int row = rowb + ai * 128 + m * 16; const float s = rsqrtf(ssq[row0 + row] * (1.0f / D_) + RMS_EPS);
#pragma unroll
                for (int bj = 0; bj < 2; ++bj) { float v[8]; ACC8(v, acc[ai][bj][m], s); *(u32x4*)(UP + (size_t)row * NUP + colb + bj * 128) = pack8(v); } }
    }
};


__device__ __forceinline__ float dpp_shr0(float x, int) { return x; }
#define DPP_SHR_Z(x, n) __builtin_bit_cast(float, __builtin_amdgcn_update_dpp(0, __builtin_bit_cast(int, (x)), 0x110 + (n), 0xf, 0xf, true))
#define DPP_SHR_OLD(old, x, n) __builtin_bit_cast(float, __builtin_amdgcn_update_dpp(__builtin_bit_cast(int, (old)), __builtin_bit_cast(int, (x)), 0x110 + (n), 0xf, 0xf, false))
#define DPP_BCAST15(x) __builtin_bit_cast(float, __builtin_amdgcn_mov_dpp(__builtin_bit_cast(int, (x)), 0x15F, 0xf, 0xf, false))
#define DPP_ROR(x, n) __builtin_bit_cast(float, __builtin_amdgcn_mov_dpp(__builtin_bit_cast(int, (x)), 0x120 + (n), 0xf, 0xf, false))

struct EpiProjF {
    static constexpr bool PERM = true, AFTER_DRAIN = false, MID = false;
    const float* rstd; const float* lb; bf16_t *UG, *QD, *KD, *V, *G, *GS5, *GH; float* EGL;
    __device__ __forceinline__ void operator()(const f32x4 (&acc)[2][2][4][2], const Unit& u, int wr, int wc, int fr, int fq) const {
        const int rowb = u.pm * 256 + wr * 64 + fr, cb = wc * 32 + 8 * fq, pn = u.pn;
        if (pn >= 20) {
            const int col = (pn - 20) * 128 + cb;
#pragma unroll
            for (int ai = 0; ai < 2; ++ai)
#pragma unroll
                for (int m = 0; m < 4; ++m) { const int row = rowb + ai * 128 + m * 16; const float s = rstd[row] * -1.4426950408889634f; float a0[8], a1[8], r[8], g[8]; ACC8(a0, acc[ai][0][m], s); ACC8(a1, acc[ai][1][m], s);
#pragma unroll
                    for (int j = 0; j < 8; ++j) { const float p0 = 1.0f + __builtin_amdgcn_exp2f(a0[j]), p1 = 1.0f + __builtin_amdgcn_exp2f(a1[j]), t = __builtin_amdgcn_rcpf(p0 * p1); g[j] = t * p0; r[j] = p1 * p1 * t; }
                    *(u32x4*)(GS5 + (size_t)row * D_ + col) = pack8(r); *(u32x4*)(GH + (size_t)row * D_ + col) = pack8(g); }
            return;
        }
        if (pn >= 4 && pn < 12) {
            const int ch = (pn - 4) * 128 + cb; const int lane = fq * 16 + fr;
#pragma unroll
            for (int ai = 0; ai < 2; ++ai) { u32x2 hq[4], hk[4];
#pragma unroll
                for (int n = 0; n < 2; ++n) {
                    const f32x4 l0 = *(const f32x4*)(lb + ch + 4 * n);
                    float bsum[4][4], kk[4][4];
#pragma unroll
                    for (int m = 0; m < 4; ++m) { const float s = rstd[rowb + ai * 128 + m * 16]; const f32x4 z = acc[ai][1][m][n] * s;
#pragma unroll
                        for (int j = 0; j < 4; ++j) { const float lbv = l0[j]; const float em = __expf(-fmaxf(z[j], -80.0f)), sg = __builtin_amdgcn_rcpf(1.0f + em); float x = __logf(lbv + (1.0f - lbv) * sg); kk[m][j] = (1.0f - lbv) * (em * sg);
                            x += DPP_SHR_Z(x, 1); x += DPP_SHR_Z(x, 2); x += DPP_SHR_Z(x, 4); x += DPP_SHR_Z(x, 8); bsum[m][j] = x; } }
#pragma unroll
                    for (int j = 0; j < 4; ++j) { float carry = 0.f;
#pragma unroll
                        for (int m = 0; m < 4; ++m) { const float tot = DPP_BCAST15(bsum[m][j]); bsum[m][j] += carry; carry += tot; } }
#pragma unroll
                    for (int m = 0; m < 4; ++m) { const int row = rowb + ai * 128 + m * 16; const float s = rstd[row]; const f32x4 q = acc[ai][0][m][n] * s; float oq[4], ok[4];
#pragma unroll
                        for (int j = 0; j < 4; ++j) { const float eb = __expf(bsum[m][j]), pq = 1.0f + __expf(-q[j]), t = __builtin_amdgcn_rcpf(pq * eb); oq[j] = q[j] * (t * eb) * eb; ok[j] = kk[m][j] * (t * pq); }
                        u32x2 wq, wk; wq.x = pg8::cvt_pk_bf16(oq[0], oq[1]); wq.y = pg8::cvt_pk_bf16(oq[2], oq[3]); wk.x = pg8::cvt_pk_bf16(ok[0], ok[1]); wk.y = pg8::cvt_pk_bf16(ok[2], ok[3]);
                        if (n == 0) { hq[m] = wq; hk[m] = wk; }
                        else { u32x4 a; a.x = hq[m].x; a.y = hq[m].y; a.z = wq.x; a.w = wq.y; *(u32x4*)(QD + (size_t)row * HW + ch) = a; u32x4 b; b.x = hk[m].x; b.y = hk[m].y; b.z = wk.x; b.w = wk.y; *(u32x4*)(KD + (size_t)row * HW + ch) = b; } }
                    if (fr == 15) { const int chunk = (u.pm * 256 + ai * 128 + wr * 64) >> 6;
                        *(f32x4*)(EGL + (size_t)chunk * HW + ch + 4 * n) = (f32x4){__expf(bsum[3][0]), __expf(bsum[3][1]), __expf(bsum[3][2]), __expf(bsum[3][3])}; }
                    asm volatile("" ::: "memory");
                } }
            return;
        }
#pragma unroll
        for (int ai = 0; ai < 2; ++ai)
#pragma unroll
            for (int m = 0; m < 4; ++m) {
                const int row = rowb + ai * 128 + m * 16; const float s = rstd[row];
#pragma unroll
                for (int bj = 0; bj < 2; ++bj) {
                    float v[8]; ACC8(v, acc[ai][bj][m], s);
                    if (pn < 4) { const int col = pn * 256 + bj * 128 + cb, g = col >> 4, c = col & 15, b = row >> 12, t = row & 4095;
                        *(u32x4*)(UG + (((size_t)(b * 64 + g) * L_ + t) * 16 + c)) = pack8(v); }
                    else if (pn < 16) { const int col = (pn - 12) * 256 + bj * 128 + cb; *(u32x4*)(V + (size_t)row * HW + col) = pack8(v); }
                    else if (pn < 20) { const int col = (pn - 16) * 256 + bj * 128 + cb; float o[8];
#pragma unroll
                        for (int j = 0; j < 8; ++j) o[j] = silu_f(v[j]);
                        *(u32x4*)(G + (size_t)row * HW + col) = pack8(o); }
                    else { const int col = ((pn - 20) & 7) * 256 + bj * 128 + cb; float o[8];
#pragma unroll
                        for (int j = 0; j < 8; ++j) o[j] = sigmoid_f(v[j]);
                        *(u32x4*)((pn < 28 ? GS5 : GH) + (size_t)row * D_ + col) = pack8(o); }
                }
            }
    }
};

template <bool XL> struct EpiUpConvT {
    static constexpr bool PERM = true, AFTER_DRAIN = false, MID = false;
    const float* ssq; const float* cw; const float* cb; bf16_t* ACT; bf16_t* RAW; LAS unsigned char* xl;
    __device__ __forceinline__ void operator()(const f32x4 (&acc)[2][2][4][2], const Unit& u, int wr, int wc, int fr, int fq) const {
        const int rowb = u.pm * 256 + wr * 64 + fr, j0 = u.pn * 128 + wc * 32 + 8 * fq;
        float rs[2][4];
#pragma unroll
        for (int ai = 0; ai < 2; ++ai)
#pragma unroll
            for (int m = 0; m < 4; ++m) rs[ai][m] = rsqrtf(ssq[rowb + ai * 128 + m * 16] * (1.0f / D_) + RMS_EPS);
        if constexpr (XL) {
#pragma unroll
            for (int n = 0; n < 2; ++n)
#pragma unroll
                for (int ai = 0; ai < 2; ++ai) { const f32x4 tg = acc[ai][0][3][n] * rs[ai][3], tv = acc[ai][1][3][n] * rs[ai][3];
                    if (fr >= 14) { LAS f32x4* p = (LAS f32x4*)xl + ((((((ai * 2 + wr) * 4 + wc) * 2 + n) * 2 + (fr & 1)) * 4 + fq) * 2); p[0] = tg; p[1] = tv; } }
            asm volatile("s_waitcnt lgkmcnt(0)" ::: "memory"); __builtin_amdgcn_s_barrier();
        }
#pragma unroll
        for (int n = 0; n < 2; ++n) { const int j = j0 + 4 * n;
            const f32x4 g0 = *(const f32x4*)(cw + j), g1 = *(const f32x4*)(cw + NUP + j), g2 = *(const f32x4*)(cw + 2 * NUP + j), gb = *(const f32x4*)(cb + j);
            const f32x4 v0 = *(const f32x4*)(cw + FF + j), v1 = *(const f32x4*)(cw + NUP + FF + j), v2 = *(const f32x4*)(cw + 2 * NUP + FF + j), vb = *(const f32x4*)(cb + FF + j);
#pragma unroll
            for (int ai = 0; ai < 2; ++ai) { const int blk = (u.pm * 256 + ai * 128 + wr * 64) >> 6, b = ai * 2 + wr; f32x4 pg = (f32x4){0.f, 0.f, 0.f, 0.f}, pv = pg;
                const bool top = !XL || b == 0, bot = !XL || b == 3;
                if constexpr (XL) { if (b > 0) { const LAS f32x4* p = (const LAS f32x4*)xl + (((((b - 1) * 4 + wc) * 2 + n) * 2 + (fr & 1)) * 4 + fq) * 2; pg = p[0]; pv = p[1]; } }
#pragma unroll
                for (int m = 0; m < 4; ++m) { const int row = rowb + ai * 128 + m * 16; f32x4 ug = acc[ai][0][m][n] * rs[ai][m], uv = acc[ai][1][m][n] * rs[ai][m]; f32x4 cg, cv;
#pragma unroll
                    for (int e = 0; e < 4; ++e) { float ugs = ug[e], uvs = uv[e], pgs = pg[e], pvs = pv[e]; asm volatile("" : "+v"(ugs), "+v"(uvs), "+v"(pgs), "+v"(pvs));
                        float g1s, g2s, v1s, v2s;
                        if (m == 0 && !XL) { g1s = DPP_SHR_Z(ugs, 1); g2s = DPP_SHR_Z(ugs, 2); v1s = DPP_SHR_Z(uvs, 1); v2s = DPP_SHR_Z(uvs, 2); }
                        else { g1s = DPP_SHR_OLD(DPP_ROR(pgs, 1), ugs, 1); g2s = DPP_SHR_OLD(DPP_ROR(pgs, 2), ugs, 2); v1s = DPP_SHR_OLD(DPP_ROR(pvs, 1), uvs, 1); v2s = DPP_SHR_OLD(DPP_ROR(pvs, 2), uvs, 2); }
                        asm volatile("" : "+v"(g1s), "+v"(g2s), "+v"(v1s), "+v"(v2s));
                        cg[e] = gb[e] + g0[e] * g2s + g1[e] * g1s + g2[e] * ugs; cv[e] = vb[e] + v0[e] * v2s + v1[e] * v1s + v2[e] * uvs; ug[e] = ugs; uv[e] = uvs; }
                    if (m > 0 || fr >= 2 || !top) { u32x2 o; o.x = pg8::cvt_pk_bf16(silu_f(cg[0]) * cv[0], silu_f(cg[1]) * cv[1]); o.y = pg8::cvt_pk_bf16(silu_f(cg[2]) * cv[2], silu_f(cg[3]) * cv[3]); *(u32x2*)((char*)ACT + ((unsigned)row * (unsigned)FF + (unsigned)j) * 2u) = o; }
                    if ((m == 0 && fr < 2 && top) || (m == 3 && fr >= 14 && bot)) { char* r = (char*)RAW + (((unsigned)blk * 4u + (unsigned)(m == 0 ? 2 + fr : fr - 14)) * (unsigned)NUP + (unsigned)j) * 2u; u32x2 a2, b2; a2.x = pg8::cvt_pk_bf16(ug[0], ug[1]); a2.y = pg8::cvt_pk_bf16(ug[2], ug[3]); b2.x = pg8::cvt_pk_bf16(uv[0], uv[1]); b2.y = pg8::cvt_pk_bf16(uv[2], uv[3]);
                        *(u32x2*)r = a2; *(u32x2*)(r + 2 * FF) = b2; }
                    pg = ug; pv = uv; } } }
    }
};
typedef EpiUpConvT<false> EpiUpConv;
__device__ __forceinline__ f32x4 ld4bf(const bf16_t* p) { const u32x2 w = *(const u32x2*)p; return (f32x4){__uint_as_float(w.x << 16), __uint_as_float(w.x & 0xffff0000u), __uint_as_float(w.y << 16), __uint_as_float(w.y & 0xffff0000u)}; }
__device__ __forceinline__ void conv_fixup(const bf16_t* RAW, const float* cw, const float* cb, bf16_t* ACT, int blk0, int nblk, int tid0, int nthreads) {
#pragma unroll 4
    for (int it = tid0; it < nblk * (FF / 4); it += nthreads) { const int blk = blk0 + it / (FF / 4), j = (it % (FF / 4)) * 4; const bool first = (blk & 63) == 0;
        const bf16_t* rp = RAW + (size_t)(blk - 1) * 4 * NUP; const bf16_t* rc = RAW + (size_t)blk * 4 * NUP; const f32x4 z4 = (f32x4){0.f, 0.f, 0.f, 0.f};
        f32x4 g[4], v[4];
        g[0] = first ? z4 : ld4bf(rp + j); g[1] = first ? z4 : ld4bf(rp + NUP + j); g[2] = ld4bf(rc + 2 * NUP + j); g[3] = ld4bf(rc + 3 * NUP + j);
        v[0] = first ? z4 : ld4bf(rp + FF + j); v[1] = first ? z4 : ld4bf(rp + NUP + FF + j); v[2] = ld4bf(rc + 2 * NUP + FF + j); v[3] = ld4bf(rc + 3 * NUP + FF + j);
        const f32x4 g0 = *(const f32x4*)(cw + j), g1 = *(const f32x4*)(cw + NUP + j), g2 = *(const f32x4*)(cw + 2 * NUP + j), gb = *(const f32x4*)(cb + j);
        const f32x4 v0 = *(const f32x4*)(cw + FF + j), v1 = *(const f32x4*)(cw + NUP + FF + j), v2 = *(const f32x4*)(cw + 2 * NUP + FF + j), vb = *(const f32x4*)(cb + FF + j);
#pragma unroll
        for (int pos = 0; pos < 2; ++pos) { const f32x4 cg = gb + g0 * g[pos] + g1 * g[pos + 1] + g2 * g[pos + 2], cv = vb + v0 * v[pos] + v1 * v[pos + 1] + v2 * v[pos + 2];
            u32x2 o; o.x = pg8::cvt_pk_bf16(silu_f(cg[0]) * cv[0], silu_f(cg[1]) * cv[1]); o.y = pg8::cvt_pk_bf16(silu_f(cg[2]) * cv[2], silu_f(cg[3]) * cv[3]); *(u32x2*)(ACT + ((size_t)blk * 64 + pos) * FF + j) = o; } }
}
__global__ void __launch_bounds__(512, 2) k_conv_fixup(const bf16_t* RAW, const float* cw, const float* cb, bf16_t* ACT) { conv_fixup(RAW, cw, cb, ACT, 0, 256, blockIdx.x * 512 + threadIdx.x, gridDim.x * 512); }

__global__ void __launch_bounds__(512, 2) k_gemm_pair(pg8::Gemm g, EpiMerged E) {
    extern __shared__ __attribute__((aligned(16))) unsigned char lds[];
    pg8::PairOrder S; S.init(g.M, g.N, (int)gridDim.x, (int)blockIdx.x);
    pg8::gemm_phase<EpiMerged, pg8::PairOrder, true, true>((LAS unsigned char*)lds, g, S, E);
}
struct EpiNull {
    static constexpr bool PERM = true, AFTER_DRAIN = false, MID = false;
    float* sink;
    __device__ __forceinline__ void operator()(const f32x4 (&acc)[2][2][4][2], const Unit& u, int wr, int wc, int fr, int fq) const {
        f32x4 s = (f32x4){0.f, 0.f, 0.f, 0.f};
#pragma unroll
        for (int ai = 0; ai < 2; ++ai)
#pragma unroll
            for (int bj = 0; bj < 2; ++bj)
#pragma unroll
                for (int m = 0; m < 4; ++m) { s += acc[ai][bj][m][0]; s += acc[ai][bj][m][1]; }
        sink[(size_t)blockIdx.x * 512 + threadIdx.x] = (s[0] + s[1]) + (s[2] + s[3]) + (float)(u.pm + u.pn + wr + wc + fr + fq);
    }
};
struct EpiStoreOnly {
    static constexpr bool PERM = true, AFTER_DRAIN = false, MID = false;
    bf16_t* dst; int nslot, pad;
    __device__ __forceinline__ void operator()(const f32x4 (&acc)[2][2][4][2], const Unit& u, int wr, int wc, int fr, int fq) const {
        const int slot = (u.pm * 36 + u.pn) & 511; bf16_t* base = dst + (size_t)slot * 65536;
#pragma unroll
        for (int ai = 0; ai < 2; ++ai)
#pragma unroll
            for (int m = 0; m < 4; ++m)
#pragma unroll
                for (int bj = 0; bj < 2; ++bj) { float v[8]; ACC8(v, acc[ai][bj][m], 1.0f); *(u32x4*)(base + (size_t)(ai * 128 + wr * 64 + m * 16 + fr) * 256 + bj * 128 + wc * 32 + 8 * fq) = pack8(v); }
    }
};
struct EpiStoreHalf {
    static constexpr bool PERM = true, AFTER_DRAIN = false, MID = false;
    bf16_t* dst; int nslot, pad;
    __device__ __forceinline__ void operator()(const f32x4 (&acc)[2][2][4][2], const Unit& u, int wr, int wc, int fr, int fq) const {
        const int slot = (u.pm * 36 + u.pn) & 511; bf16_t* base = dst + (size_t)slot * 65536;
#pragma unroll
        for (int ai = 0; ai < 2; ++ai)
#pragma unroll
            for (int m = 0; m < 4; ++m) { float v[8], v2[8]; ACC8(v, acc[ai][0][m], 1.0f); ACC8(v2, acc[ai][1][m], 1.0f);
#pragma unroll
                for (int j = 0; j < 8; ++j) v[j] += v2[j];
                *(u32x4*)(base + (size_t)(ai * 128 + wr * 64 + m * 16 + fr) * 256 + wc * 32 + 8 * fq) = pack8(v); }
    }
};
struct EpiStoreFull {
    static constexpr bool PERM = true, AFTER_DRAIN = false, MID = false;
    bf16_t* dst; int nslot, pad;
    __device__ __forceinline__ void operator()(const f32x4 (&acc)[2][2][4][2], const Unit& u, int wr, int wc, int fr, int fq) const {
        const int slot = (u.pm * 36 + u.pn) & 511; bf16_t* base = dst + (size_t)slot * 65536; const int lane = fq * 16 + fr, w = wr * 4 + wc;
#pragma unroll
        for (int ai = 0; ai < 2; ++ai)
#pragma unroll
            for (int m = 0; m < 4; ++m)
#pragma unroll
                for (int bj = 0; bj < 2; ++bj) { float v[8]; ACC8(v, acc[ai][bj][m], 1.0f); const int k = (ai * 4 + m) * 2 + bj;
                    *(u32x4*)(base + (size_t)w * 8192 + (size_t)(8 * k + (lane >> 3)) * 64 + (lane & 7) * 8) = pack8(v); }
    }
};
template <class Epi> __global__ void __launch_bounds__(512, 2) k_gemm(pg8::Gemm g, Epi E) {
    extern __shared__ __attribute__((aligned(16))) unsigned char lds[];
    pg8::StaticOrder S; S.init(g.M, g.N, (int)gridDim.x, (int)blockIdx.x);
    pg8::gemm_phase<Epi, pg8::StaticOrder, true, true>((LAS unsigned char*)lds, g, S, E);
}

__device__ __forceinline__ int dest_row(int mode, int n) {
    if (mode == 1) { if (n >= 1024 && n < 2048) { const int i = n - 1024; return 1024 + 256 * (i >> 7) + (i & 127); } if (n >= 2048 && n < 3072) { const int i = n - 2048; return 1024 + 256 * (i >> 7) + 128 + (i & 127); }
        if (n >= 5120 && n < 7168) { const int i = n - 5120; return 5120 + 256 * (i >> 7) + (i & 127); } if (n >= 7168) { const int i = n - 7168; return 5120 + 256 * (i >> 7) + 128 + (i & 127); }
        return n; }
    if (mode == 2) { if (n < FF) return 256 * (n >> 7) + (n & 127); const int i = n - FF; return 256 * (i >> 7) + 128 + (i & 127); }
    return n;
}
__device__ __forceinline__ void transpose_item(const float* W, const float* gain, int K, int N, bf16_t* WT, int mode, LAS float* scr, int item, int lane) {
    const int nblk = N / 64, kb = item / nblk, nb = item % nblk, k0 = 64 * kb, n0 = 64 * nb;
    float v[64];
#pragma unroll
    for (int i = 0; i < 64; ++i) v[i] = __builtin_nontemporal_load(W + (size_t)(k0 + i) * N + n0 + lane);
    if (gain) {
#pragma unroll
        for (int i = 0; i < 64; ++i) v[i] *= gain[k0 + i]; }
#pragma unroll
    for (int i = 0; i < 64; ++i) scr[i * 65 + lane] = v[i];
    asm volatile("s_waitcnt lgkmcnt(0)" ::: "memory");
    const int c = lane & 7; const int r0 = dest_row(mode, n0);
#pragma unroll
    for (int j = 0; j < 8; ++j) { const int n = (lane >> 3) + 8 * j; const LAS float* s = scr + (8 * c) * 65 + n;
        u32x4 o; o.x = pg8::cvt_pk_bf16(s[0 * 65], s[1 * 65]); o.y = pg8::cvt_pk_bf16(s[2 * 65], s[3 * 65]); o.z = pg8::cvt_pk_bf16(s[4 * 65], s[5 * 65]); o.w = pg8::cvt_pk_bf16(s[6 * 65], s[7 * 65]);
        *(u32x4*)(WT + (size_t)(r0 + n) * K + k0 + 8 * c) = o; }
    asm volatile("s_waitcnt lgkmcnt(0)" ::: "memory");
}
#ifndef ROW_BAL
#define ROW_BAL 1
#endif
#ifndef XROWS
#define XROWS 2
#endif
#ifndef P2_PREP_FIRST
#define P2_PREP_FIRST 1
#endif
#ifndef P2_UP
#define P2_UP 5632
#endif
#ifndef PREP_RN
#define PREP_RN 9216
#endif
#ifndef PREP_NA
#define PREP_NA 6912
#endif
struct PrepArgs { const float *x, *ln_mix_g, *w_in, *w_glu, *w_ps5, *w_ph, *w_out, *ln_ffn_g, *w_up, *w_down, *lb_logits; unsigned char* ws; };
__device__ __forceinline__ void prep_phase(const PrepArgs& a, LAS unsigned char* lds, int gw, int ngw, int lane, int ntabw = 0) {
    LAS float* scr = (LAS float*)(lds + (threadIdx.x >> 6) * 16640);
    unsigned char* ws = a.ws;
    constexpr int I_IN = (D_ / 64) * (NIN / 64), I_GLU = (W5 / 64) * (W5 / 64), I_PS = (W5 / 64) * (D_ / 64), I_OUT = (D_ / 64) * (D_ / 64), I_UP = (D_ / 64) * (NUP / 64), I_DN = (FF / 64) * (D_ / 64);
    constexpr int NITEMS = I_IN + I_GLU + 2 * I_PS + I_OUT + I_UP + I_DN;
    const bool tabw = gw >= ngw - ntabw;
    constexpr int NITEMS_M = NITEMS - I_DN - P2_UP;
    const int i0 = ntabw ? (tabw ? PREP_NA + (gw - (ngw - ntabw)) : gw) : gw, i1 = ntabw ? (tabw ? NITEMS_M : PREP_NA) : NITEMS, ist = ntabw ? (tabw ? ntabw : ngw - ntabw) : ngw;
    for (int it = i0; it < i1; it += ist) {
        int r = it;
        if (ntabw) {
            if (r < I_UP - P2_UP) { transpose_item(a.w_up, a.ln_ffn_g, D_, NUP, (bf16_t*)(ws + WS_WUP), 2, scr, r + P2_UP, lane); continue; } r -= I_UP - P2_UP;
            if (r < I_IN) { transpose_item(a.w_in, a.ln_mix_g, D_, NIN, (bf16_t*)(ws + WS_WIN), 1, scr, r, lane); continue; } r -= I_IN;
        } else {
        if (r < I_UP) { transpose_item(a.w_up, a.ln_ffn_g, D_, NUP, (bf16_t*)(ws + WS_WUP), 2, scr, r, lane); continue; } r -= I_UP;
        if (r < I_IN) { transpose_item(a.w_in, a.ln_mix_g, D_, NIN, (bf16_t*)(ws + WS_WIN), 1, scr, r, lane); continue; } r -= I_IN;
        if (r < I_DN) { transpose_item(a.w_down, nullptr, FF, D_, (bf16_t*)(ws + WS_WDOWN), 0, scr, r, lane); continue; } r -= I_DN; }
        if (r < I_OUT) { transpose_item(a.w_out, nullptr, D_, D_, (bf16_t*)(ws + WS_WOUT), 0, scr, r, lane); continue; } r -= I_OUT;
        if (r < I_PS) { transpose_item(a.w_ps5, nullptr, W5, D_, (bf16_t*)(ws + WS_WPS5), 0, scr, r, lane); continue; } r -= I_PS;
        if (r < I_PS) { transpose_item(a.w_ph, nullptr, HW, D_, (bf16_t*)(ws + WS_WPH), 0, scr, r, lane); continue; } r -= I_PS;
        transpose_item(a.w_glu, nullptr, W5, W5, (bf16_t*)(ws + WS_WGLU), 0, scr, r, lane);
    }
    bf16_t* XB = (bf16_t*)(ws + WS_XB); float* rstd1 = (float*)(ws + WS_RSTD1);
    const int r0_ = ntabw ? (tabw ? PREP_RN + (gw - (ngw - ntabw)) : gw) : gw, r1_ = ntabw ? (tabw ? T_ : PREP_RN) : T_;
    int rb0 = r0_, rb1 = r1_, rbs = ist;
    if (ntabw && !tabw && ROW_BAL) { static_assert(PREP_RN == 768 * 12, "row balance"); rbs = 768; if (gw < 768) { rb0 = gw; rb1 = 768 * 5; } else { rb0 = 768 * 5 + (gw - 768); rb1 = PREP_RN; } }
    for (int row = rb0; row < rb1; row += XROWS * rbs) {
        f32x4 v[XROWS][8];
#pragma unroll
        for (int q = 0; q < XROWS; ++q) { const int rq = (row + q * rbs < rb1) ? row + q * rbs : row; const f32x4* xr = (const f32x4*)(a.x + (size_t)rq * D_) + lane;
#pragma unroll
            for (int j = 0; j < 8; ++j) v[q][j] = __builtin_nontemporal_load(xr + 64 * j); }
#pragma unroll
        for (int q = 0; q < XROWS; ++q) { const int rq = row + q * rbs; if (rq < rb1) { float s = 0.f;
#pragma unroll
            for (int j = 0; j < 8; ++j) { const f32x4 w = v[q][j]; s += (w[0] * w[0] + w[1] * w[1]) + (w[2] * w[2] + w[3] * w[3]);
                uint2 o; o.x = pg8::cvt_pk_bf16(w[0], w[1]); o.y = pg8::cvt_pk_bf16(w[2], w[3]); *((uint2*)(XB + (size_t)rq * D_) + lane + 64 * j) = o; }
#pragma unroll
            for (int o = 1; o < 64; o <<= 1) s += __shfl_xor(s, o);
            if (lane == 0) rstd1[rq] = rsqrtf(s * (1.0f / D_) + RMS_EPS); } }
    }
    float* LB = (float*)(ws + WS_LB);
    for (int c = gw * 64 + lane; c < HW; c += ngw * 64) { const float l0 = a.lb_logits[c], l1 = a.lb_logits[HW + c]; LB[c] = 1.0f / (1.0f + __expf(l1 - l0)); }
}
__global__ void __launch_bounds__(512, 2) k_prep(PrepArgs a) {
    extern __shared__ __attribute__((aligned(16))) unsigned char lds[];
    prep_phase(a, (LAS unsigned char*)lds, (int)blockIdx.x * 8 + (int)(threadIdx.x >> 6), (int)gridDim.x * 8, (int)(threadIdx.x & 63));
}

__global__ void k_cumsum(const bf16_t* SQ, const float* LOGF, const bf16_t* KKR, bf16_t* QD, bf16_t* KD, float* EGL) {
    const int col = blockIdx.x * blockDim.x + threadIdx.x, chunk = blockIdx.y; float b = 0.f;
    for (int s = 0; s < 64; ++s) { const size_t o = (size_t)(chunk * 64 + s) * HW + col; b += LOGF[o];
        QD[o] = (bf16_t)(pg8::cvt_pk_bf16(bf2f(SQ[o]) * __expf(b), 0.f) & 0xffff); KD[o] = (bf16_t)(pg8::cvt_pk_bf16(bf2f(KKR[o]) * __expf(-b), 0.f) & 0xffff); }
    EGL[(size_t)chunk * HW + col] = __expf(b);
}
struct S5Args { const bf16_t* UG; const float *a_re, *a_im, *log_dt, *b_re, *b_im, *c_re, *c_im, *d; bf16_t* Z; };
__device__ __forceinline__ void sincos_rev(float x, float& s, float& c) { float r = x * 0.15915494309189535f; r -= rintf(r); s = __builtin_amdgcn_sinf(r); c = __builtin_amdgcn_cosf(r); }
__global__ void __launch_bounds__(64) k_s5_naive(S5Args a) {
    const int b = blockIdx.x >> 6, g = blockIdx.x & 63, p = threadIdx.x;
    __shared__ float H[16][128]; __shared__ float CC[16][128]; __shared__ float Us[16][16];
    const float lr = fminf(a.a_re[g * 64 + p], -1e-4f), li = a.a_im[g * 64 + p], dt = __expf(a.log_dt[g]);
    float sn, cs; sincos_rev(li * dt, sn, cs); const float mag = __expf(lr * dt), abr = mag * cs, abi = mag * sn;
    const float den = lr * lr + li * li, nr = abr - 1.0f, ni = abi, cr = (nr * lr + ni * li) / den, ci = (ni * lr - nr * li) / den;
    float Bcr[16], Bci[16];
#pragma unroll
    for (int c = 0; c < 16; ++c) { const float br = a.b_re[(g * 64 + p) * 16 + c], bi = a.b_im[(g * 64 + p) * 16 + c]; Bcr[c] = cr * br - ci * bi; Bci[c] = cr * bi + ci * br;
        CC[c][p] = a.c_re[(g * 16 + c) * 64 + p]; CC[c][64 + p] = -a.c_im[(g * 16 + c) * 64 + p]; }
    float hr = 0.f, hi = 0.f;
    const bf16_t* U = a.UG + (size_t)(b * 64 + g) * L_ * 16;
    for (int t0 = 0; t0 < L_; t0 += 16) {
        __syncthreads();
#pragma unroll
        for (int q = 0; q < 4; ++q) { const int idx = p * 4 + q; Us[idx >> 4][idx & 15] = bf2f(U[(size_t)t0 * 16 + idx]); }
        __syncthreads();
#pragma unroll
        for (int s = 0; s < 16; ++s) { float br = 0.f, bi = 0.f;
#pragma unroll
            for (int c = 0; c < 16; ++c) { br += Bcr[c] * Us[s][c]; bi += Bci[c] * Us[s][c]; }
            const float nhr = abr * hr - abi * hi + br, nhi = abr * hi + abi * hr + bi; hr = nhr; hi = nhi; H[s][p] = hr; H[s][64 + p] = hi; }
        __syncthreads();
#pragma unroll
        for (int q = 0; q < 4; ++q) { const int idx = p * 4 + q, s = idx >> 4, c = idx & 15; float y = a.d[g * 16 + c] * Us[s][c];
            for (int k = 0; k < 128; ++k) y += H[s][k] * CC[c][k];
            a.Z[(size_t)(b * L_ + t0 + s) * W5 + g * 16 + c] = (bf16_t)(pg8::cvt_pk_bf16(gelu_tanh_f(y), 0.f) & 0xffff); }
    }
}
__global__ void __launch_bounds__(128) k_hgrn_naive(const bf16_t* SQ, const float* LOGF, const bf16_t* KKR, const bf16_t* V, float* ORAW) {
    const int b = blockIdx.x >> 3, h = blockIdx.x & 7, d = threadIdx.x;
    __shared__ float fs[128], ks[128], qs[128];
    float S[128];
#pragma unroll
    for (int k = 0; k < 128; ++k) S[k] = 0.f;
    for (int t = 0; t < L_; ++t) { const size_t o = (size_t)(b * L_ + t) * HW + h * 128 + d;
        __syncthreads();
        fs[d] = __expf(LOGF[o]); ks[d] = bf2f(KKR[o]); qs[d] = bf2f(SQ[o]);
        const float v = bf2f(V[o]);
        __syncthreads();
        float acc = 0.f;
#pragma unroll
        for (int k = 0; k < 128; ++k) { S[k] = fs[k] * S[k] + ks[k] * v; acc += qs[k] * S[k]; }
        ORAW[o] = acc; }
}
__global__ void __launch_bounds__(64) k_oh_naive(const float* ORAW, const bf16_t* G, const float* norm_g, bf16_t* OH) {
    const int row = blockIdx.x >> 3, h = blockIdx.x & 7, lane = threadIdx.x; const size_t o = (size_t)row * HW + h * 128;
    const float o0 = ORAW[o + lane], o1 = ORAW[o + 64 + lane]; float s = o0 * o0 + o1 * o1;
#pragma unroll
    for (int k = 1; k < 64; k <<= 1) s += __shfl_xor(s, k);
    const float r = rsqrtf(s * (1.0f / 128.0f) + RMS_EPS);
    OH[o + lane] = (bf16_t)(pg8::cvt_pk_bf16(o0 * r * norm_g[h * 128 + lane] * bf2f(G[o + lane]), 0.f) & 0xffff);
    OH[o + 64 + lane] = (bf16_t)(pg8::cvt_pk_bf16(o1 * r * norm_g[h * 128 + 64 + lane] * bf2f(G[o + 64 + lane]), 0.f) & 0xffff);
}
__global__ void k_conv_naive(const bf16_t* UPQ, const float* cw, const float* cb, bf16_t* ACT, int row0) {
    const int j = blockIdx.x * blockDim.x + threadIdx.x, t = blockIdx.y; if (j >= FF) return;
    const int cg = 256 * (j >> 7) + (j & 127), cv = cg + 128; float g = cb[j], v = cb[FF + j];
#pragma unroll
    for (int k = 0; k < 3; ++k) { const int tt = t - 2 + k; if (tt >= 0) { g += cw[k * NUP + j] * bf2f(UPQ[(size_t)tt * NUP + cg]); v += cw[k * NUP + FF + j] * bf2f(UPQ[(size_t)tt * NUP + cv]); } }
    ACT[(size_t)(row0 + t) * FF + j] = (bf16_t)(pg8::cvt_pk_bf16(silu_f(g) * v, 0.f) & 0xffff);
}
__global__ void __launch_bounds__(256) k_final(float* out, const float* ssq, const float* g) {
    const int row = blockIdx.x; const float r = rsqrtf(ssq[row] * (1.0f / D_) + RMS_EPS);
    f32x4* o = (f32x4*)(out + (size_t)row * D_); const f32x4* gg = (const f32x4*)g;
    for (int i = threadIdx.x; i < D_ / 4; i += 256) o[i] = o[i] * r * gg[i];
}


typedef pg8::bf16x8 bf16x8;
typedef short s16x4_t __attribute__((ext_vector_type(4)));
__device__ __forceinline__ bf16x8 tr_pair(const LAS unsigned char* p0, const LAS unsigned char* p1) {
    const s16x4_t lo = __builtin_bit_cast(s16x4_t, __builtin_amdgcn_ds_read_tr16_b64_v4i16((LAS s16x4_t*)p0));
    const s16x4_t hi = __builtin_bit_cast(s16x4_t, __builtin_amdgcn_ds_read_tr16_b64_v4i16((LAS s16x4_t*)p1));
    return __builtin_shufflevector(lo, hi, 0, 1, 2, 3, 4, 5, 6, 7);
}
#define MFMA16(a, b, c) __builtin_amdgcn_mfma_f32_16x16x32_bf16((a), (b), (c), 0, 0, 0)

struct HgrnArgs { const bf16_t* QD; const bf16_t* KD; const float* EGL; const bf16_t* V; bf16_t* ORAW; float* SSQH; };
#define WG_BAR() do { asm volatile("s_waitcnt lgkmcnt(0)" ::: "memory"); __builtin_amdgcn_s_barrier(); asm volatile("" ::: "memory"); } while (0)
constexpr int HG_QS = 0, HG_KS = 17408, HG_VS = 34816, HG_TILE = 39936, HG_PS = 3 * HG_TILE, HG_ST = HG_PS + 2 * 9216, HG_END = HG_ST + 2 * 8704;
__device__ __forceinline__ void hgrn_unit(const HgrnArgs& a, LAS unsigned char* lds, int unit) {
    int tid_ = threadIdx.x; asm volatile("" : "+v"(tid_));
    const int tid = tid_, lane = tid & 63, w = __builtin_amdgcn_readfirstlane(tid >> 6), li = lane & 15, q4 = lane >> 4;
    const int b = unit >> 5, h = (unit >> 2) & 7, dq = unit & 3;
    const size_t rowbase = (size_t)b * L_;
    const int colq = h * 128, colv = h * 128 + dq * 32;
    for (int i = tid; i < 2 * 8704 / 4; i += 512) ((LAS unsigned*)(lds + HG_ST))[i] = 0u;
    u32x4 rqA[2], rkA[2], rvA = (u32x4){0u, 0u, 0u, 0u}, rqB[2], rkB[2], rvB = (u32x4){0u, 0u, 0u, 0u};
#define HG_LOAD(rq, rk, rv, c) do { const size_t r0 = rowbase + (size_t)(c) * 64; _Pragma("unroll") for (int i = 0; i < 2; ++i) { const int idx = tid + 512 * i, row = idx >> 4, c16 = idx & 15; \
        rq[i] = *(const u32x4*)(a.QD + (r0 + row) * HW + colq + c16 * 8); rk[i] = *(const u32x4*)(a.KD + (r0 + row) * HW + colq + c16 * 8); } \
        if (tid < 256) rv = *(const u32x4*)(a.V + (r0 + (tid >> 2)) * HW + colv + (tid & 3) * 8); } while (0)
#define HG_WRITE(rq, rk, rv, tb) do { LAS unsigned char* tp = lds + (tb) * HG_TILE; _Pragma("unroll") for (int i = 0; i < 2; ++i) { const int idx = tid + 512 * i, row = idx >> 4, c16 = idx & 15; \
        *(LAS u32x4*)(tp + HG_QS + (row * 136 + c16 * 8) * 2) = rq[i]; *(LAS u32x4*)(tp + HG_KS + (row * 136 + c16 * 8) * 2) = rk[i]; } \
        if (tid < 256) *(LAS u32x4*)(tp + HG_VS + ((tid >> 2) * 40 + (tid & 3) * 8) * 2) = rv; } while (0)
    HG_LOAD(rqA, rkA, rvA, 0); HG_LOAD(rqB, rkB, rvB, 1); HG_WRITE(rqA, rkA, rvA, 0); HG_WRITE(rqB, rkB, rvB, 1);
    HG_LOAD(rqA, rkA, rvA, 2); HG_LOAD(rqB, rkB, rvB, 3);
    __syncthreads();
    f32x4 Sacc[2] = {(f32x4){0.f, 0.f, 0.f, 0.f}, (f32x4){0.f, 0.f, 0.f, 0.f}};
    f32x4 eglA = *(const f32x4*)(a.EGL + (size_t)(b * 64) * HW + colq + w * 16 + 4 * q4), eglB = *(const f32x4*)(a.EGL + (size_t)(b * 64 + 1) * HW + colq + w * 16 + 4 * q4);
    int tb3 = 0;
#define HG_CHUNK(c, RQ, RK, RV, EGL4) do { \
        const int p = (c) & 1; const LAS unsigned char* tp = lds + tb3 * HG_TILE; const LAS unsigned char* QS = tp + HG_QS; const LAS unsigned char* KS = tp + HG_KS; const LAS unsigned char* VS = tp + HG_VS; \
        LAS unsigned char* PSp = lds + HG_PS + p * 9216; const LAS unsigned char* STr = lds + HG_ST + p * 8704; LAS unsigned char* STw = lds + HG_ST + (p ^ 1) * 8704; \
          \
        _Pragma("unroll") for (int tt = 0; tt < 2; ++tt) { const int t = 2 * w + tt, sb = t >> 2, tbk = t & 3; f32x4 acc = (f32x4){0.f, 0.f, 0.f, 0.f}; \
            if (sb <= tbk) { _Pragma("unroll") for (int ks = 0; ks < 4; ++ks) { const bf16x8 A = *(const LAS bf16x8*)(KS + ((sb * 16 + li) * 136 + ks * 32 + 8 * q4) * 2), B = *(const LAS bf16x8*)(QS + ((tbk * 16 + li) * 136 + ks * 32 + 8 * q4) * 2); acc = MFMA16(A, B, acc); } } \
            const int s0 = sb * 16 + 4 * q4, tq = tbk * 16 + li; float mm[4]; \
            _Pragma("unroll") for (int r = 0; r < 4; ++r) mm[r] = (s0 + r <= tq) ? acc[r] : 0.f; \
            u32x2 o; o.x = pg8::cvt_pk_bf16(mm[0], mm[1]); o.y = pg8::cvt_pk_bf16(mm[2], mm[3]); *(LAS u32x2*)(PSp + (tq * 72 + s0) * 2) = o; } \
        f32x4 dS[2]; \
        _Pragma("unroll") for (int nb = 0; nb < 2; ++nb) { f32x4 acc = (f32x4){0.f, 0.f, 0.f, 0.f}; \
            _Pragma("unroll") for (int ks = 0; ks < 2; ++ks) { const LAS unsigned char* kp = KS + ((ks * 32 + 8 * q4 + (li >> 2)) * 136 + w * 16 + 4 * (li & 3)) * 2; const bf16x8 A = tr_pair(kp, kp + 4 * 136 * 2); \
                const LAS unsigned char* vp = VS + ((ks * 32 + 8 * q4 + (li >> 2)) * 40 + nb * 16 + 4 * (li & 3)) * 2; const bf16x8 B = tr_pair(vp, vp + 4 * 40 * 2); acc = MFMA16(A, B, acc); } \
            dS[nb] = acc; } \
        WG_BAR(); \
          \
        { const int tbo = w >> 1, nb = w & 1; f32x4 acc = (f32x4){0.f, 0.f, 0.f, 0.f}; \
            _Pragma("unroll") for (int ks = 0; ks < 2; ++ks) { if (ks == 0 || tbo >= 2) { const bf16x8 A = *(const LAS bf16x8*)(PSp + ((tbo * 16 + li) * 72 + ks * 32 + 8 * q4) * 2); \
                const LAS unsigned char* vp = VS + ((ks * 32 + 8 * q4 + (li >> 2)) * 40 + nb * 16 + 4 * (li & 3)) * 2; const bf16x8 B = tr_pair(vp, vp + 4 * 40 * 2); acc = MFMA16(B, A, acc); } } \
            _Pragma("unroll") for (int ks = 0; ks < 4; ++ks) { const bf16x8 A = *(const LAS bf16x8*)(QS + ((tbo * 16 + li) * 136 + ks * 32 + 8 * q4) * 2), B = *(const LAS bf16x8*)(STr + ((nb * 16 + li) * 136 + ks * 32 + 8 * q4) * 2); acc = MFMA16(B, A, acc); } \
              \
            const size_t rt = rowbase + (size_t)(c) * 64 + tbo * 16 + li; \
            { u32x2 ob; ob.x = pg8::cvt_pk_bf16(acc[0], acc[1]); ob.y = pg8::cvt_pk_bf16(acc[2], acc[3]); *(u32x2*)(a.ORAW + rt * HW + colv + nb * 16 + 4 * q4) = ob; } float ss = (acc[0] * acc[0] + acc[1] * acc[1]) + (acc[2] * acc[2] + acc[3] * acc[3]); ss += __shfl_xor(ss, 16); ss += __shfl_xor(ss, 32); \
            if (q4 == 0) a.SSQH[(rt * 8 + h) * 8 + dq * 2 + nb] = ss; } \
        _Pragma("unroll") for (int nb = 0; nb < 2; ++nb) { Sacc[nb] = (Sacc[nb] + dS[nb]) * EGL4; \
            u32x2 o; o.x = pg8::cvt_pk_bf16(Sacc[nb][0], Sacc[nb][1]); o.y = pg8::cvt_pk_bf16(Sacc[nb][2], Sacc[nb][3]); *(LAS u32x2*)(STw + ((nb * 16 + li) * 136 + w * 16 + 4 * q4) * 2) = o; } \
        if ((c) + 2 < 64) EGL4 = *(const f32x4*)(a.EGL + (size_t)(b * 64 + (c) + 2) * HW + colq + w * 16 + 4 * q4); \
        { const int tbw = (tb3 >= 1) ? tb3 - 1 : 2;                     \
          if ((c) + 2 < 64) HG_WRITE(RQ, RK, RV, tbw); \
          if ((c) + 4 < 64) HG_LOAD(RQ, RK, RV, (c) + 4); } \
        tb3 = (tb3 == 2) ? 0 : tb3 + 1; \
    } while (0)
    for (int c = 0; c < 64; c += 2) { HG_CHUNK(c, rqA, rkA, rvA, eglA); HG_CHUNK(c + 1, rqB, rkB, rvB, eglB); }
#undef HG_CHUNK
#undef HG_LOAD
#undef HG_WRITE
}
__device__ __forceinline__ void oh_rows(const bf16_t* ORAW, const float* SSQH, const bf16_t* G, const float* norm_g, bf16_t* OH, int gw, int ngw, int lane) {
    for (int row = gw; row < T_; row += ngw) { const int hcol = lane * 16, h = lane >> 3; const size_t o = (size_t)row * HW + hcol;
        const f32x4 p0 = *(const f32x4*)(SSQH + ((size_t)row * 8 + h) * 8), p1 = *(const f32x4*)(SSQH + ((size_t)row * 8 + h) * 8 + 4);
        const float r = rsqrtf(((p0[0] + p0[1]) + (p0[2] + p0[3]) + (p1[0] + p1[1]) + (p1[2] + p1[3])) * (1.0f / 128.0f) + RMS_EPS);
#pragma unroll
        for (int hh = 0; hh < 2; ++hh) { float ov[8]; unpack8(*(const u32x4*)(ORAW + o + hh * 8), ov); const f32x4 a0 = (f32x4){ov[0], ov[1], ov[2], ov[3]}, a1 = (f32x4){ov[4], ov[5], ov[6], ov[7]}, n0 = *(const f32x4*)(norm_g + hcol + hh * 8), n1 = *(const f32x4*)(norm_g + hcol + hh * 8 + 4);
            float g[8], v[8]; unpack8(*(const u32x4*)(G + o + hh * 8), g);
#pragma unroll
            for (int j = 0; j < 4; ++j) { v[j] = a0[j] * r * n0[j] * g[j]; v[4 + j] = a1[j] * r * n1[j] * g[4 + j]; }
            *(u32x4*)(OH + o + hh * 8) = pack8(v); } }
}

constexpr int S5_KT = 0, S5_E = 9216, S5_F = S5_E + 65536, S5_AB = S5_F + 65536, S5_GSTRIDE = S5_AB + 512;
struct S5In { const float *a_re, *a_im, *log_dt, *b_re, *b_im, *c_re, *c_im, *d; };
__device__ __forceinline__ void s5_tables(const S5In& in, unsigned char* tabs, LAS unsigned char* lds, int g) {
    const int tid = threadIdx.x;
    LAS float* PWr = (LAS float*)lds; LAS float* PWi = PWr + 17 * 64; LAS float* Bcr = PWi + 17 * 64; LAS float* Bci = Bcr + 1024; LAS float* Ccr = Bci + 1024; LAS float* Cci = Ccr + 1024;
    unsigned char* tab = tabs + (size_t)g * S5_GSTRIDE;
    { const float dt = __expf(in.log_dt[g]);
        for (int idx = tid; idx < 17 * 64; idx += 512) { const int j = idx >> 6, p = idx & 63; const float lr = fminf(in.a_re[g * 64 + p], -1e-4f), li = in.a_im[g * 64 + p], th = li * dt, mm = lr * dt;
            float sn, cs; sincos_rev(th * (float)j, sn, cs); const float mag = __expf(mm * (float)j); PWr[j * 64 + p] = mag * cs; PWi[j * 64 + p] = mag * sn; } }
    for (int i = tid; i < 1024; i += 512) { Ccr[i] = in.c_re[g * 1024 + i]; Cci[i] = in.c_im[g * 1024 + i]; }
    __syncthreads();
    for (int idx = tid; idx < 1024; idx += 512) { const int p = idx >> 4, c = idx & 15; const float lr = fminf(in.a_re[g * 64 + p], -1e-4f), li = in.a_im[g * 64 + p];
        const float abr = PWr[64 + p], abi = PWi[64 + p], den = lr * lr + li * li, nr = abr - 1.0f, ni = abi, cr = (nr * lr + ni * li) / den, ci = (ni * lr - nr * li) / den;
        const float br = in.b_re[(g * 64 + p) * 16 + c], bi = in.b_im[(g * 64 + p) * 16 + c]; Bcr[p * 16 + c] = cr * br - ci * bi; Bci[p * 16 + c] = cr * bi + ci * br; }
    if (tid < 64) { ((float*)(tab + S5_AB))[2 * tid] = PWr[16 * 64 + tid]; ((float*)(tab + S5_AB))[2 * tid + 1] = PWi[16 * 64 + tid]; }
    __syncthreads();
    bf16_t* KT = (bf16_t*)(tab + S5_KT); bf16_t* E = (bf16_t*)(tab + S5_E); bf16_t* F = (bf16_t*)(tab + S5_F);
    if (tid < 256) KT[tid] = 0;
    { const int e0 = tid * 8, tau = e0 >> 8, c = (e0 >> 4) & 15, cp0 = e0 & 15; float acc[8] = {0.f, 0.f, 0.f, 0.f, 0.f, 0.f, 0.f, 0.f};
        for (int p = 0; p < 64; ++p) { const float pr = PWr[tau * 64 + p], pi = PWi[tau * 64 + p], cr = Ccr[c * 64 + p], ci = Cci[c * 64 + p];
#pragma unroll
            for (int i = 0; i < 8; ++i) { const float br = Bcr[p * 16 + cp0 + i], bi = Bci[p * 16 + cp0 + i]; acc[i] += cr * (pr * br - pi * bi) - ci * (pr * bi + pi * br); } }
#pragma unroll
        for (int i = 0; i < 8; ++i) if (tau == 0 && c == cp0 + i) acc[i] += in.d[g * 16 + c];
        u32x4 o; o.x = pg8::cvt_pk_bf16(acc[0], acc[1]); o.y = pg8::cvt_pk_bf16(acc[2], acc[3]); o.z = pg8::cvt_pk_bf16(acc[4], acc[5]); o.w = pg8::cvt_pk_bf16(acc[6], acc[7]); *(u32x4*)(KT + 256 + e0) = o; }
    for (int i = 0; i < 8; ++i) { const int e0 = (tid + 512 * i) * 8, r = e0 >> 8, k = e0 & 255, sx = k >> 4, cp0 = k & 15, p = r & 63; const float pr = PWr[(15 - sx) * 64 + p], pi = PWi[(15 - sx) * 64 + p]; float v[8];
#pragma unroll
        for (int q = 0; q < 8; ++q) { const float br = Bcr[p * 16 + cp0 + q], bi = Bci[p * 16 + cp0 + q]; v[q] = r < 64 ? pr * br - pi * bi : pr * bi + pi * br; }
        u32x4 o; o.x = pg8::cvt_pk_bf16(v[0], v[1]); o.y = pg8::cvt_pk_bf16(v[2], v[3]); o.z = pg8::cvt_pk_bf16(v[4], v[5]); o.w = pg8::cvt_pk_bf16(v[6], v[7]); *(u32x4*)(E + e0) = o; }
    for (int i = 0; i < 8; ++i) { const int e0 = (tid + 512 * i) * 8, row = e0 >> 7, k = e0 & 127, t = row >> 4, c = row & 15, p0 = k & 63; float v[8];
#pragma unroll
        for (int q = 0; q < 8; ++q) { const float pr = PWr[(t + 1) * 64 + p0 + q], pi = PWi[(t + 1) * 64 + p0 + q], cr = Ccr[c * 64 + p0 + q], ci = Cci[c * 64 + p0 + q]; v[q] = k < 64 ? cr * pr - ci * pi : -(cr * pi + ci * pr); }
        u32x4 o; o.x = pg8::cvt_pk_bf16(v[0], v[1]); o.y = pg8::cvt_pk_bf16(v[2], v[3]); o.z = pg8::cvt_pk_bf16(v[4], v[5]); o.w = pg8::cvt_pk_bf16(v[6], v[7]); *(u32x4*)(F + e0) = o; }
    __syncthreads();
}
struct S5FArgs { const bf16_t* UG; const unsigned char* tabs; bf16_t* Z; };
constexpr int S5_US = 0  , S5_EUS = 67584, S5_HS = 101376, S5_KTS = 118784, S5_TOT = 127488, S5_LDS_END = 131584;
__device__ __forceinline__ void s5_unit(const S5FArgs& a, LAS unsigned char* lds, int unit) {
    int tid_ = threadIdx.x; asm volatile("" : "+v"(tid_));
    const int tid = tid_, lane = tid & 63, w = __builtin_amdgcn_readfirstlane(tid >> 6), li = lane & 15, q4 = lane >> 4;
    const int b = unit >> 6, g = unit & 63;
    const unsigned char* tab = a.tabs + (size_t)g * S5_GSTRIDE;
    const bf16_t* E = (const bf16_t*)(tab + S5_E); const bf16_t* F = (const bf16_t*)(tab + S5_F);
    const bf16_t* U = a.UG + (size_t)(b * 64 + g) * L_ * 16;
    u32x4 ru[4];
#define S5_ULOAD(seg) do { _Pragma("unroll") for (int i = 0; i < 4; ++i) ru[i] = *(const u32x4*)(U + (size_t)(seg) * 16384 + (size_t)(tid + 512 * i) * 8); } while (0)
#define S5_UWRITE(buf) do { _Pragma("unroll") for (int i = 0; i < 4; ++i) { const int idx = tid + 512 * i, n = idx >> 5, c16 = idx & 31; *(LAS u32x4*)(lds + S5_US + (buf) * 33792 + (n * 264 + c16 * 8) * 2) = ru[i]; } } while (0)
    S5_ULOAD(0);
    WG_BAR();
    for (int i = tid; i < 544; i += 512) *(LAS u32x4*)(lds + S5_KTS + i * 16) = *(const u32x4*)(tab + S5_KT + i * 16);
    bf16x8 Ef[8], Ff[2][4];
#pragma unroll
    for (int ks = 0; ks < 8; ++ks) Ef[ks] = *(const bf16x8*)(E + (w * 16 + li) * 256 + ks * 32 + 8 * q4);
#pragma unroll
    for (int tt = 0; tt < 2; ++tt) { const int t = tt ? 15 - w : w;
#pragma unroll
        for (int ks = 0; ks < 4; ++ks) Ff[tt][ks] = *(const bf16x8*)(F + (t * 16 + li) * 128 + ks * 32 + 8 * q4); }
    const float abr = ((const float*)(tab + S5_AB))[2 * lane], abi = ((const float*)(tab + S5_AB))[2 * lane + 1];
    float a8r = abr, a8i = abi;
#pragma unroll
    for (int k = 0; k < 3; ++k) { const float nr = a8r * a8r - a8i * a8i, ni = 2.0f * a8r * a8i; a8r = nr; a8i = ni; }
    float hsr = 0.f, hsi = 0.f;
    S5_UWRITE(0); S5_ULOAD(1);
    for (int seg = 0; seg < 4; ++seg) {
        const LAS unsigned char* US = lds + S5_US + (seg & 1) * 33792;
        WG_BAR();
#pragma unroll
        for (int nb = 0; nb < 4; ++nb) { f32x4 acc = (f32x4){0.f, 0.f, 0.f, 0.f};
#pragma unroll
            for (int ks = 0; ks < 8; ++ks) { const bf16x8 B = *(const LAS bf16x8*)(US + ((nb * 16 + li) * 264 + ks * 32 + 8 * q4) * 2); acc = MFMA16(Ef[ks], B, acc); }
            *(LAS f32x4*)(lds + S5_EUS + ((nb * 16 + li) * 132 + w * 16 + 4 * q4) * 4) = acc; }
        WG_BAR();
        float lr[8], lim[8];
        { float er[8], ei[8];
#pragma unroll
          for (int j = 0; j < 8; ++j) { er[j] = *(const LAS float*)(lds + S5_EUS + ((8 * w + j) * 132 + lane) * 4); ei[j] = *(const LAS float*)(lds + S5_EUS + ((8 * w + j) * 132 + 64 + lane) * 4); }
          float hr = 0.f, hi = 0.f;
#pragma unroll
          for (int j = 0; j < 8; ++j) { lr[j] = hr; lim[j] = hi; const float nhr = abr * hr - abi * hi + er[j], nhi = abr * hi + abi * hr + ei[j]; hr = nhr; hi = nhi; }
          *(LAS float*)(lds + S5_TOT + (w * 128 + lane) * 4) = hr; *(LAS float*)(lds + S5_TOT + (w * 128 + 64 + lane) * 4) = hi; }
        WG_BAR();
        { float gr = hsr, gi = hsi, mr = 0.f, mi = 0.f;
#pragma unroll
          for (int k = 0; k < 8; ++k) { if (k == w) { mr = gr; mi = gi; } const float tr_ = *(const LAS float*)(lds + S5_TOT + (k * 128 + lane) * 4), ti_ = *(const LAS float*)(lds + S5_TOT + (k * 128 + 64 + lane) * 4);
              const float nr = a8r * gr - a8i * gi + tr_, ni = a8r * gi + a8i * gr + ti_; gr = nr; gi = ni; }
          hsr = gr; hsi = gi;
#pragma unroll
          for (int j = 0; j < 8; ++j) { const int n = 8 * w + j;
              *(LAS bf16_t*)(lds + S5_HS + (n * 136 + lane) * 2) = (bf16_t)(pg8::cvt_pk_bf16(lr[j] + mr, 0.f) & 0xffff); *(LAS bf16_t*)(lds + S5_HS + (n * 136 + 64 + lane) * 2) = (bf16_t)(pg8::cvt_pk_bf16(lim[j] + mi, 0.f) & 0xffff);
              const float nr = abr * mr - abi * mi, ni = abr * mi + abi * mr; mr = nr; mi = ni; } }
        WG_BAR();
#pragma unroll
        for (int tt = 0; tt < 2; ++tt) { const int t = tt ? 15 - w : w;
#pragma unroll
            for (int nb = 0; nb < 4; ++nb) { f32x4 acc = (f32x4){0.f, 0.f, 0.f, 0.f};
                for (int ks = 0; ks <= (t >> 1); ++ks) { const int ti = t - 2 * ks - (q4 >> 1) + 1; const bf16x8 A = *(const LAS bf16x8*)(lds + S5_KTS + (ti * 256 + li * 16 + 8 * (q4 & 1)) * 2);
                    const bf16x8 B = *(const LAS bf16x8*)(US + ((nb * 16 + li) * 264 + ks * 32 + 8 * q4) * 2); acc = MFMA16(A, B, acc); }
#pragma unroll
                for (int ks = 0; ks < 4; ++ks) { const bf16x8 B = *(const LAS bf16x8*)(lds + S5_HS + ((nb * 16 + li) * 136 + ks * 32 + 8 * q4) * 2); acc = MFMA16(Ff[tt][ks], B, acc); }
                const size_t tok = (size_t)b * L_ + seg * 1024 + (nb * 16 + li) * 16 + t; u32x2 o; o.x = pg8::cvt_pk_bf16(gelu_tanh_f(acc[0]), gelu_tanh_f(acc[1])); o.y = pg8::cvt_pk_bf16(gelu_tanh_f(acc[2]), gelu_tanh_f(acc[3]));
                *(u32x2*)(a.Z + tok * W5 + g * 16 + 4 * q4) = o; } }
        if (seg + 1 < 4) { S5_UWRITE((seg + 1) & 1); if (seg + 2 < 4) S5_ULOAD(seg + 2); }
    }
#undef S5_ULOAD
#undef S5_UWRITE
}
__global__ void __launch_bounds__(512, 2) k_hgrn_fast(HgrnArgs a) { extern __shared__ __attribute__((aligned(16))) unsigned char lds[]; for (int u = blockIdx.x; u < 128; u += gridDim.x) { hgrn_unit(a, (LAS unsigned char*)lds, u); __syncthreads(); } }
__global__ void __launch_bounds__(512, 2) k_s5_fast(S5FArgs a) { extern __shared__ __attribute__((aligned(16))) unsigned char lds[]; for (int u = blockIdx.x; u < 256; u += gridDim.x) s5_unit(a, (LAS unsigned char*)lds, u); }
__global__ void __launch_bounds__(512, 2) k_s5_tab(S5In in, unsigned char* tabs) { extern __shared__ __attribute__((aligned(16))) unsigned char lds[]; s5_tables(in, tabs, (LAS unsigned char*)lds, blockIdx.x); }
__global__ void __launch_bounds__(512, 2) k_oh_fast(const bf16_t* ORAW, const float* SSQH, const bf16_t* G, const float* norm_g, bf16_t* OH) { oh_rows(ORAW, SSQH, G, norm_g, OH, blockIdx.x * 8 + (threadIdx.x >> 6), gridDim.x * 8, threadIdx.x & 63); }

__host__ __device__ __forceinline__ pg8::Gemm mk_gemm(const void* A, const void* Bt, int M, int N, int K) { pg8::Gemm g{}; g.A = g.A2 = (const bf16_t*)A; g.Bt = g.Bt2 = (const bf16_t*)Bt; g.M = M; g.N = N; g.K = K; return g; }

#define XB_TMO      128
#define XB_XCNT(j)  (256  + 64 * (j))
#define XB_XSUB(j)  (1280 + 64 * (j))
#define XB_XGEN(j)  (2304 + 64 * (j))
#define XB_TOP      3328
#define XB_TOPGEN   3392
#define XCD_BAR_WORDS 3456
#define XB_SPIN_CAP (1u << 18)
__device__ __forceinline__ unsigned xb_ld(unsigned* p)              { return __hip_atomic_load(p, __ATOMIC_RELAXED, __HIP_MEMORY_SCOPE_AGENT); }
__device__ __forceinline__ unsigned xb_add(unsigned* p, unsigned v) { return __hip_atomic_fetch_add(p, v, __ATOMIC_RELAXED, __HIP_MEMORY_SCOPE_AGENT); }
__device__ __forceinline__ unsigned xb_xcc_id() { return (unsigned)__builtin_amdgcn_s_getreg((3 << 11) | 20) & 0xFu; }
#define XB_SPIN(cond, bar) do { unsigned _sp = 0; while (cond) { __builtin_amdgcn_s_sleep(1); \
    if ((++_sp & 255u) == 0u) { if (xb_ld(&(bar)[XB_TMO])) break; if (_sp > XB_SPIN_CAP) { atomicAdd(&(bar)[XB_TMO], 1u); break; } } } } while (0)
struct XcdBarrier { unsigned* bar; unsigned x; volatile LAS unsigned* st; };
__device__ __forceinline__ XcdBarrier xcd_barrier_post(unsigned* bar, volatile LAS unsigned* st) {
    XcdBarrier b; b.bar = bar; b.x = xb_xcc_id(); b.st = st;
    if (threadIdx.x == 0) (void)xb_add(&bar[XB_XCNT(b.x)], 1u);
    return b;
}
__device__ __forceinline__ void xcd_barrier_complete(unsigned* bar, unsigned x, unsigned& nloc, unsigned& nx) {
    const unsigned G = gridDim.x * gridDim.y * gridDim.z;
    unsigned sum, cnt, mine, sp = 0u;
    for (;;) {
        sum = 0u; cnt = 0u; mine = 0u;
#pragma unroll
        for (unsigned j = 0; j < 16; ++j) { const unsigned c = xb_ld(&bar[XB_XCNT(j)]); sum += c; cnt += (c > 0u) ? 1u : 0u; mine = (j == x) ? c : mine; }
        if (sum == G) break;
        __builtin_amdgcn_s_sleep(1);
        if ((++sp & 255u) == 0u) { if (xb_ld(&bar[XB_TMO])) break; if (sp > XB_SPIN_CAP) { atomicAdd(&bar[XB_TMO], 1u); break; } }
    }
    nloc = mine > 0u ? mine : 1u; nx = cnt > 0u ? cnt : 1u;
}
__device__ __forceinline__ void xcd_barrier(const XcdBarrier& b) {
    asm volatile("s_waitcnt vmcnt(0)" ::: "memory");
    __syncthreads();
    if (threadIdx.x == 0) {
        unsigned* bar = b.bar;
        __builtin_amdgcn_s_waitcnt(0);
        unsigned nloc = b.st[0], nx = b.st[1];
        if (nloc == 0u) { xcd_barrier_complete(bar, b.x, nloc, nx); b.st[0] = nloc; b.st[1] = nx; }
        const unsigned old = xb_add(&bar[XB_XSUB(b.x)], 1u);
        const unsigned gen = old / nloc;
        if (old + 1u == (gen + 1u) * nloc) {
            __builtin_amdgcn_fence(__ATOMIC_RELEASE, "agent");
            asm volatile("s_waitcnt vmcnt(0)" ::: "memory");
            const unsigned og = xb_add(&bar[XB_TOP], 1u);
            const unsigned tg = og / nx;
            if (og + 1u == (tg + 1u) * nx) xb_add(&bar[XB_TOPGEN], 1u);
            else XB_SPIN(xb_ld(&bar[XB_TOPGEN]) == tg, bar);
            __builtin_amdgcn_fence(__ATOMIC_ACQUIRE, "agent");
            xb_add(&bar[XB_XGEN(b.x)], 1u);
            asm volatile("s_waitcnt vmcnt(0)" ::: "memory");
        } else {
            XB_SPIN(xb_ld(&bar[XB_XGEN(b.x)]) == gen, bar);
            __builtin_amdgcn_fence(__ATOMIC_ACQUIRE, "agent");
            asm volatile("s_waitcnt vmcnt(0)" ::: "memory");
        }
    }
    __syncthreads();
}
constexpr int CW_BAR = 4096;
constexpr int MISC_OFF = 163584;
#ifndef CONV_XL
#define CONV_XL 1
#endif
#ifndef HG_GATE_UNITS
#define HG_GATE_UNITS 4
#endif
#ifndef N_CG_SYNC
#define N_CG_SYNC 0
#endif
struct MegaArgs { const float* in[24]; float* out; unsigned char* ws; };
__device__ __forceinline__ const float* in_ptr(const MegaArgs& a, int i) { unsigned long long p = (unsigned long long)a.in[i]; asm volatile("" : "+s"(p)); return (const float*)(const __attribute__((address_space(1))) float*)p; }
__global__ void __launch_bounds__(512, 2) k_mega(MegaArgs a) {
    extern __shared__ __attribute__((aligned(16))) unsigned char lds_[];
    LAS unsigned char* lds = (LAS unsigned char*)lds_;
    cg::grid_group grid = cg::this_grid();
    volatile LAS unsigned* misc = (volatile LAS unsigned*)(lds + MISC_OFF);
    if (threadIdx.x < 64) misc[threadIdx.x] = 0u;
    __syncthreads();
    unsigned char* ws = a.ws; float* out = a.out;
#define GASP __attribute__((address_space(1)))
#define PHASE_PTRS() do { unsigned long long w_ = (unsigned long long)a.ws, o_ = (unsigned long long)a.out; asm volatile("" : "+s"(w_), "+s"(o_)); ws = (unsigned char*)(GASP unsigned char*)w_; out = (float*)(GASP float*)o_; } while (0)
#define INP(i) in_ptr(a, (i))
    XcdBarrier bar = xcd_barrier_post((unsigned*)(ws + WS_CTL) + CW_BAR, misc + 8);
    int seam = 0;
#ifndef PROBE_PHASE
#define PROBE_PHASE -1
#endif
#ifndef REPEAT_PHASE
#define REPEAT_PHASE -1
#endif
#ifndef SKEW_LO
#define SKEW_LO 0
#define SKEW_HI 7
#endif
#ifndef SKEW_SPLIT
#define SKEW_SPLIT 0
#define SKEW_SPLIT_NEG 0
#endif
#define REPS(k) _Pragma("unroll") for (int rep = 0; rep < ((REPEAT_PHASE == (k)) ? 2 : 1); ++rep)
    unsigned long long* tsb = (unsigned long long*)(a.ws + 15 * MiB);
#define STAMP() do { if (PROBE_PHASE >= 0 && blockIdx.x == 0 && threadIdx.x == 0) tsb[seam] = __builtin_amdgcn_s_memrealtime(); } while (0)
#define SEAM() do { if (REPEAT_PHASE == 70 && threadIdx.x == 0) { asm volatile("s_waitcnt vmcnt(0)" ::: "memory"); const unsigned t_ = (unsigned)__builtin_amdgcn_s_memrealtime(); if (SKEW_SPLIT > 0) atomicMax(&bar.bar[3600 + 2 * seam + ((int)blockIdx.x >= SKEW_SPLIT ? 1 : 0)], t_); else { atomicMax(&bar.bar[3600 + 2 * seam], t_); atomicMax(&bar.bar[3601 + 2 * seam], 0xFFFFFFFFu - t_); } } \
    if (seam < N_CG_SYNC) grid.sync(); else xcd_barrier(bar); ++seam; STAMP(); } while (0)
#define SSQ2 ((float*)(ws + CTL_SSQ2))
#define SSQ3 ((float*)(ws + CTL_SSQ3))
#define GS5P ((bf16_t*)out)
#define GHP ((bf16_t*)out + (size_t)T_ * D_)
    const int G = (int)gridDim.x, bx = (int)blockIdx.x, wave = __builtin_amdgcn_readfirstlane((int)(threadIdx.x >> 6)), lane = (int)(threadIdx.x & 63);
    STAMP();
    PHASE_PTRS();
    REPS(0) {
    if (bx >= G - 64) { S5In in{}; in.a_re = INP(3); in.a_im = INP(4); in.log_dt = INP(5); in.b_re = INP(6); in.b_im = INP(7); in.c_re = INP(8); in.c_im = INP(9); in.d = INP(10); s5_tables(in, ws + WS_S5TAB, lds, bx - (G - 64)); }
    { PrepArgs p{}; p.x = INP(0); p.ln_mix_g = INP(1); p.w_in = INP(2); p.w_glu = INP(11); p.w_ps5 = INP(13); p.w_ph = INP(16); p.w_out = INP(17); p.ln_ffn_g = INP(18); p.w_up = INP(19); p.w_down = INP(22); p.lb_logits = INP(14); p.ws = ws;
      prep_phase(p, lds, bx * 8 + wave, G * 8, lane, 64 * 8); }
    __syncthreads(); }
    SEAM();
    PHASE_PTRS();
    REPS(1) { EpiProjF E{}; E.rstd = (const float*)(ws + WS_RSTD1); E.lb = (const float*)(ws + WS_LB); E.UG = (bf16_t*)(ws + WS_UG); E.QD = (bf16_t*)(ws + WS_QD); E.KD = (bf16_t*)(ws + WS_KD); E.V = (bf16_t*)(ws + WS_V);
      E.G = (bf16_t*)(ws + WS_G); E.GS5 = GS5P; E.GH = GHP; E.EGL = (float*)(ws + WS_EGL);
      const pg8::Gemm g = mk_gemm(ws + WS_XB, ws + WS_WIN, T_, 20 * 256, D_); pg8::StaticOrder S; S.init(g.M, g.N, G, bx); pg8::gemm_phase<EpiProjF, pg8::StaticOrder, true, true>(lds, g, S, E); }
    if (REPEAT_PHASE == 30) { EpiNull E{}; E.sink = (float*)(ws + 14 * MiB); const pg8::Gemm g = mk_gemm(ws + WS_XB, ws + WS_WIN, T_, NIN, D_); pg8::StaticOrder S; S.init(g.M, g.N, G, bx); pg8::gemm_phase<EpiNull, pg8::StaticOrder, true, true>(lds, g, S, E); }
    if (REPEAT_PHASE == 31) { EpiNull E{}; E.sink = (float*)(ws + 14 * MiB); const pg8::Gemm g = mk_gemm(ws + WS_XB, ws + WS_WIN, T_, NIN, D_); pg8::StaticOrder S; S.init(g.M, g.N, G, bx); pg8::gemm_phase<EpiNull, pg8::StaticOrder, false, false>(lds, g, S, E); }
    if (REPEAT_PHASE == 33) { EpiStoreOnly E{}; E.dst = (bf16_t*)(ws + WS_ORAW); E.nslot = 512; const pg8::Gemm g = mk_gemm(ws + WS_XB, ws + WS_WIN, T_, NIN, D_); pg8::StaticOrder S; S.init(g.M, g.N, G, bx); pg8::gemm_phase<EpiStoreOnly, pg8::StaticOrder, true, true>(lds, g, S, E); }
    if (REPEAT_PHASE == 37) { EpiStoreHalf E{}; E.dst = (bf16_t*)(ws + WS_ORAW); E.nslot = 512; const pg8::Gemm g = mk_gemm(ws + WS_XB, ws + WS_WIN, T_, NIN, D_); pg8::StaticOrder S; S.init(g.M, g.N, G, bx); pg8::gemm_phase<EpiStoreHalf, pg8::StaticOrder, true, true>(lds, g, S, E); }
    if (REPEAT_PHASE == 34) { EpiStoreFull E{}; E.dst = (bf16_t*)(ws + WS_ORAW); E.nslot = 512; const pg8::Gemm g = mk_gemm(ws + WS_XB, ws + WS_WIN, T_, NIN, D_); pg8::StaticOrder S; S.init(g.M, g.N, G, bx); pg8::gemm_phase<EpiStoreFull, pg8::StaticOrder, true, true>(lds, g, S, E); }
    SEAM();
    PHASE_PTRS();
#if P2_PREP_FIRST
    if (bx >= 128) { __syncthreads();
        int tid_ = (int)threadIdx.x; asm volatile("" : "+v"(tid_)); const int w_ = __builtin_amdgcn_readfirstlane(tid_ >> 6), ln_ = tid_ & 63; LAS float* scr = (LAS float*)(lds + w_ * 16640);
        constexpr int I_DN = (FF / 64) * (D_ / 64);
        for (int j = 0; j < (I_DN + P2_UP + 1023) / 1024; ++j) { const int r = j * 1024 + (bx - 128) * 8 + w_; if (r >= I_DN + P2_UP) break;
            if (r < I_DN) transpose_item(INP(22), nullptr, FF, D_, (bf16_t*)(ws + WS_WDOWN), 0, scr, r, ln_); else transpose_item(INP(19), INP(18), D_, NUP, (bf16_t*)(ws + WS_WUP), 2, scr, r - I_DN, ln_); } }
    __syncthreads();
#endif
    REPS(2) { __syncthreads();
    if (bx < 128) { HgrnArgs h{}; h.QD = (const bf16_t*)(ws + WS_QD); h.KD = (const bf16_t*)(ws + WS_KD); h.EGL = (const float*)(ws + WS_EGL); h.V = (const bf16_t*)(ws + WS_V); h.ORAW = (bf16_t*)(ws + WS_ORAW); h.SSQH = (float*)(ws + WS_SSQH);
        for (int r2 = 0; r2 < (REPEAT_PHASE == 20 ? 2 : 1); ++r2) for (int u = bx; u < 128; u += 128) { hgrn_unit(h, lds, u); __syncthreads(); } }
    else { S5FArgs s{}; s.UG = (const bf16_t*)(ws + WS_UG); s.tabs = ws + WS_S5TAB; s.Z = (bf16_t*)(ws + WS_Z);
        for (int r2 = 0; r2 < (REPEAT_PHASE == 21 ? 2 : 1); ++r2) for (int u = bx - 128; u < 256; u += G - 128) s5_unit(s, lds, u); } }
    { __syncthreads(); EpiProjF E{}; E.rstd = (const float*)(ws + WS_RSTD1); E.lb = (const float*)(ws + WS_LB); E.UG = (bf16_t*)(ws + WS_UG); E.QD = (bf16_t*)(ws + WS_QD); E.KD = (bf16_t*)(ws + WS_KD); E.V = (bf16_t*)(ws + WS_V);
      E.G = (bf16_t*)(ws + WS_G); E.GS5 = GS5P; E.GH = GHP; E.EGL = (float*)(ws + WS_EGL);
      const pg8::Gemm g = mk_gemm(ws + WS_XB, ws + WS_WIN, T_, NIN, D_); pg8::RangeOrder S; S.pn0 = 20;
      if (bx < 128) { S.first = bx * HG_GATE_UNITS; S.count = HG_GATE_UNITS; } else { S.first = 128 * HG_GATE_UNITS + (bx - 128) * (8 - HG_GATE_UNITS); S.count = 8 - HG_GATE_UNITS; }
      if (G == 256) pg8::gemm_phase<EpiProjF, pg8::RangeOrder, true, true>(lds, g, S, E); }
#if !P2_PREP_FIRST
    if (bx >= 128) { __syncthreads();
        int tid_ = (int)threadIdx.x; asm volatile("" : "+v"(tid_)); const int w_ = __builtin_amdgcn_readfirstlane(tid_ >> 6), ln_ = tid_ & 63; LAS float* scr = (LAS float*)(lds + w_ * 16640);
        constexpr int I_DN = (FF / 64) * (D_ / 64);
        for (int j = 0; j < (I_DN + P2_UP + 1023) / 1024; ++j) { const int r = j * 1024 + (bx - 128) * 8 + w_; if (r >= I_DN + P2_UP) break;
            if (r < I_DN) transpose_item(INP(22), nullptr, FF, D_, (bf16_t*)(ws + WS_WDOWN), 0, scr, r, ln_); else transpose_item(INP(19), INP(18), D_, NUP, (bf16_t*)(ws + WS_WUP), 2, scr, r - I_DN, ln_); } }
#endif
    SEAM();
    PHASE_PTRS();
    REPS(3) {
    oh_rows((const bf16_t*)(ws + WS_ORAW), (const float*)(ws + WS_SSQH), (const bf16_t*)(ws + WS_G), INP(15), (bf16_t*)(ws + WS_OH), bx * 8 + wave, G * 8, lane);
    { EpiGlu E{}; E.Z = (const bf16_t*)(ws + WS_Z); E.bias = INP(12); E.ZS = (bf16_t*)(ws + WS_ZS);
      const pg8::Gemm g = mk_gemm(ws + WS_Z, ws + WS_WGLU, T_, W5, W5); pg8::StaticOrder S; S.init(g.M, g.N, G, bx); pg8::gemm_phase<EpiGlu, pg8::StaticOrder, true, true>(lds, g, S, E); } }
    SEAM();
    PHASE_PTRS();
    REPS(4) { EpiMerged E{}; E.GS5 = GS5P; E.GH = GHP; E.MERGED = (bf16_t*)(ws + WS_MERGED);
      pg8::Gemm g = mk_gemm(ws + WS_ZS, ws + WS_WPS5, T_, D_, W5); g.A2 = (const bf16_t*)(ws + WS_OH); g.Bt2 = (const bf16_t*)(ws + WS_WPH);
      pg8::PairOrder S; S.init(g.M, g.N, G, bx); pg8::gemm_phase<EpiMerged, pg8::PairOrder, true, true>(lds, g, S, E); }
    SEAM();
    PHASE_PTRS();
    REPS(5) { EpiRes E{}; E.XI = INP(0); E.XIB = X_BF16_RESID ? (const bf16_t*)(ws + WS_XB2) : nullptr; E.XO = nullptr; E.XBF = (bf16_t*)(ws + WS_X1B); E.ssq = rep ? (float*)(ws + 14 * MiB) : SSQ2;
      const pg8::Gemm g = mk_gemm(ws + WS_MERGED, ws + WS_WOUT, T_, D_, D_); pg8::StaticOrder S; S.init(g.M, g.N, G, bx); pg8::gemm_phase<EpiRes, pg8::StaticOrder, true, true>(lds, g, S, E); }
    SEAM();
    PHASE_PTRS();
#ifndef STAGGER_P6
#define STAGGER_P6 0
#endif
    if (STAGGER_P6 > 0) { const unsigned long long t0 = __builtin_amdgcn_s_memrealtime(), dl = (unsigned long long)((bx >> 3) & 31) * STAGGER_P6; while (__builtin_amdgcn_s_memrealtime() - t0 < dl) __builtin_amdgcn_s_sleep(8); }
    REPS(6) { EpiUpConvT<CONV_XL != 0> E{}; E.ssq = SSQ2; E.cw = INP(20); E.cb = INP(21); E.ACT = (bf16_t*)(ws + WS_ACT); E.RAW = (bf16_t*)(ws + WS_RAW); E.xl = lds + 135168;
      const pg8::Gemm g = mk_gemm(ws + WS_X1B, ws + WS_WUP, T_, NUP, D_); pg8::StaticOrder S; S.init(g.M, g.N, G, bx); pg8::gemm_phase<EpiUpConvT<CONV_XL != 0>, pg8::StaticOrder, true, true>(lds, g, S, E); }
    SEAM();
    PHASE_PTRS();
    { const pg8::Gemm g = mk_gemm(ws + WS_ACT, ws + WS_WDOWN, T_, D_, FF); pg8::PanelOrder S; S.c = bx;
      int last_pm = -1; pg8::Unit u;
      for (int i = 0; S.next(i, u); ++i) if (u.pm != last_pm) { conv_fixup((const bf16_t*)(ws + WS_RAW), INP(20), INP(21), (bf16_t*)(ws + WS_ACT), 4 * u.pm, CONV_XL ? 1 : 4, (int)threadIdx.x, 512); last_pm = u.pm; }
      asm volatile("s_waitcnt vmcnt(0)" ::: "memory"); __syncthreads();
      EpiResFinal E{}; E.XO = out; E.X1 = (const bf16_t*)(ws + WS_X1B); E.ssq = SSQ3; E.cnt = (unsigned*)(ws + CTL_CNT7); E.gfin = INP(23); E.tmo = (unsigned*)(ws + CTL_CNT7) + 64 * 64;
      if (G == 256) pg8::gemm_phase<EpiResFinal, pg8::PanelOrder, true, true>(lds, g, S, E); }
    if (REPEAT_PHASE == 70 && threadIdx.x == 0) { asm volatile("s_waitcnt vmcnt(0)" ::: "memory"); const unsigned t_ = (unsigned)__builtin_amdgcn_s_memrealtime(); atomicMax(&bar.bar[3600 + 2 * 7], t_); atomicMax(&bar.bar[3601 + 2 * 7], 0xFFFFFFFFu - t_); }
    if (REPEAT_PHASE == 70) { xcd_barrier(bar); if (threadIdx.x == 0) { unsigned tot = 0; for (int q = SKEW_LO; q < SKEW_HI; ++q) { if (SKEW_SPLIT > 0) { const int d_ = (int)(xb_ld(&bar.bar[3601 + 2 * q]) - xb_ld(&bar.bar[3600 + 2 * q])); tot += (unsigned)(SKEW_SPLIT_NEG ? (d_ < 0 ? -d_ : 0) : (d_ > 0 ? d_ : 0)); } else tot += xb_ld(&bar.bar[3600 + 2 * q]) - (0xFFFFFFFFu - xb_ld(&bar.bar[3601 + 2 * q])); }
        const unsigned long long t0 = __builtin_amdgcn_s_memrealtime(); while (__builtin_amdgcn_s_memrealtime() - t0 < 4ull * tot) __builtin_amdgcn_s_sleep(8); } __syncthreads(); }
    if (PROBE_PHASE >= 0 && blockIdx.x == 0 && threadIdx.x == 0) { ++seam; tsb[seam] = __builtin_amdgcn_s_memrealtime(); asm volatile("s_waitcnt vmcnt(0) lgkmcnt(0)" ::: "memory");
        out[0] = (float)(tsb[PROBE_PHASE + 1] - tsb[PROBE_PHASE]) * 0.01f; }
#undef SEAM
#undef SSQ2
#undef SSQ3
#undef GS5P
#undef GHP
}

#ifndef DBG_STOP
#define DBG_STOP 0
#endif
#ifndef USE_FAST_HGRN
#define USE_FAST_HGRN 1
#endif
#ifndef USE_FUSED_CUMSUM
#define USE_FUSED_CUMSUM 1
#endif
#ifndef USE_FUSED_CONV
#define USE_FUSED_CONV 1
#endif
#ifndef USE_MEGA
#define USE_MEGA 1
#endif
#ifndef USE_FAST_S5
#define USE_FAST_S5 1
#endif
__global__ void k_dump_bf16(const bf16_t* src, size_t n, float* out) { for (size_t i = (size_t)blockIdx.x * blockDim.x + threadIdx.x; i < (size_t)T_ * D_; i += (size_t)gridDim.x * blockDim.x) out[i] = bf2f(src[i % n]); }
__global__ void k_dump_f32(const float* src, size_t n, float* out) { for (size_t i = (size_t)blockIdx.x * blockDim.x + threadIdx.x; i < (size_t)T_ * D_; i += (size_t)gridDim.x * blockDim.x) out[i] = src[i % n]; }
#define DUMP_BF16(stage, off, n) do { if (DBG_STOP == (stage)) { hipLaunchKernelGGL(k_dump_bf16, dim3(2048), dim3(256), 0, stream, (const bf16_t*)(ws + (off)), (size_t)(n), out); return; } } while (0)
#define DUMP_F32(stage, off, n) do { if (DBG_STOP == (stage)) { hipLaunchKernelGGL(k_dump_f32, dim3(2048), dim3(256), 0, stream, (const float*)(ws + (off)), (size_t)(n), out); return; } } while (0)
constexpr int LDS_BYTES = 163840;
template <class Epi> static void launch_gemm(const pg8::Gemm& g, const Epi& E, int grid, hipStream_t s) {
    static bool once = false; if (!once) { (void)hipFuncSetAttribute((const void*)k_gemm<Epi>, hipFuncAttributeMaxDynamicSharedMemorySize, LDS_BYTES); once = true; }
    hipLaunchKernelGGL(k_gemm<Epi>, dim3(grid), dim3(512), LDS_BYTES, s, g, E);
}

extern "C" void kernel_launch(void* const* d_in, const int* in_sizes, int n_in, void* d_out, int out_size, void* d_ws, size_t ws_size, hipStream_t stream) {
    static int grid = 0;
    if (grid == 0) { int dev = 0, cus = 0; (void)hipGetDevice(&dev); (void)hipDeviceGetAttribute(&cus, hipDeviceAttributeMultiprocessorCount, dev); grid = cus > 0 ? cus : 256;
        (void)hipFuncSetAttribute((const void*)k_prep, hipFuncAttributeMaxDynamicSharedMemorySize, LDS_BYTES);
        (void)hipFuncSetAttribute((const void*)k_gemm_pair, hipFuncAttributeMaxDynamicSharedMemorySize, LDS_BYTES);
        (void)hipFuncSetAttribute((const void*)k_hgrn_fast, hipFuncAttributeMaxDynamicSharedMemorySize, LDS_BYTES); (void)hipFuncSetAttribute((const void*)k_s5_fast, hipFuncAttributeMaxDynamicSharedMemorySize, LDS_BYTES); (void)hipFuncSetAttribute((const void*)k_s5_tab, hipFuncAttributeMaxDynamicSharedMemorySize, LDS_BYTES);
        if (ws_size < 512 * MiB) fprintf(stderr, "kernel_launch: workspace %zu < 512 MiB\n", ws_size); }
#if USE_MEGA
    { static int mgrid = 0;
      if (mgrid == 0) { int per_cu = 0; (void)hipFuncSetAttribute((const void*)k_mega, hipFuncAttributeMaxDynamicSharedMemorySize, LDS_BYTES);
          (void)hipOccupancyMaxActiveBlocksPerMultiprocessor(&per_cu, (const void*)k_mega, 512, LDS_BYTES); if (per_cu < 1) per_cu = 1; mgrid = grid * per_cu; if (mgrid > 256) mgrid = 256;
          fprintf(stderr, "k_mega: cus %d per_cu %d grid %d\n", grid, per_cu, mgrid); }
      (void)hipMemsetAsync((unsigned char*)d_ws + WS_CTL, 0, 1 * MiB, stream);
      MegaArgs a{}; for (int i = 0; i < 24; ++i) a.in[i] = (const float*)d_in[i]; a.out = (float*)d_out; a.ws = (unsigned char*)d_ws;
      void* args[] = {&a};
      hipError_t e = hipLaunchCooperativeKernel((const void*)k_mega, dim3(mgrid), dim3(512), args, LDS_BYTES, stream);
      if (e != hipSuccess) fprintf(stderr, "cooperative launch failed: %s (grid %d)\n", hipGetErrorString(e), mgrid);
      return; }
#endif
    const float* const* in = (const float* const*)d_in;
    const float *x = in[0], *ln_mix_g = in[1], *w_in = in[2], *a_re = in[3], *a_im = in[4], *log_dt = in[5], *b_re = in[6], *b_im = in[7], *c_re = in[8], *c_im = in[9], *s5d = in[10], *w_glu = in[11], *b_glu = in[12],
                *w_ps5 = in[13], *lb_logits = in[14], *norm_g = in[15], *w_ph = in[16], *w_out = in[17], *ln_ffn_g = in[18], *w_up = in[19], *conv_w = in[20], *conv_b = in[21], *w_down = in[22], *ln_final_g = in[23];
    unsigned char* ws = (unsigned char*)d_ws; float* out = (float*)d_out;
    (void)hipMemsetAsync(ws + WS_CTL, 0, 1 * MiB, stream);
    float* SSQ2 = (float*)(ws + CTL_SSQ2); float* SSQ3 = (float*)(ws + CTL_SSQ3);
#ifdef DBG_GS5WS
    bf16_t* GS5 = (bf16_t*)(ws + WS_ORAW_NAIVE); bf16_t* GH = (bf16_t*)d_out + (size_t)T_ * D_;
#else
    bf16_t* GS5 = (bf16_t*)d_out; bf16_t* GH = GS5 + (size_t)T_ * D_;
#endif
    { PrepArgs a{}; a.x = x; a.ln_mix_g = ln_mix_g; a.w_in = w_in; a.w_glu = w_glu; a.w_ps5 = w_ps5; a.w_ph = w_ph; a.w_out = w_out; a.ln_ffn_g = ln_ffn_g; a.w_up = w_up; a.w_down = w_down; a.lb_logits = lb_logits; a.ws = ws;
      hipLaunchKernelGGL(k_prep, dim3(grid), dim3(512), LDS_BYTES, stream, a); }
    DUMP_BF16(13, WS_WIN, (size_t)NIN * D_);
#if USE_FUSED_CUMSUM
    { EpiProjF E{}; E.rstd = (const float*)(ws + WS_RSTD1); E.lb = (const float*)(ws + WS_LB); E.UG = (bf16_t*)(ws + WS_UG); E.QD = (bf16_t*)(ws + WS_QD); E.KD = (bf16_t*)(ws + WS_KD); E.V = (bf16_t*)(ws + WS_V);
      E.G = (bf16_t*)(ws + WS_G); E.GS5 = GS5; E.GH = GH; E.EGL = (float*)(ws + WS_EGL);
      launch_gemm(mk_gemm(ws + WS_XB, ws + WS_WIN, T_, NIN, D_), E, grid, stream); }
#else
    { EpiProj E{}; E.rstd = (const float*)(ws + WS_RSTD1); E.lb = (const float*)(ws + WS_LB); E.UG = (bf16_t*)(ws + WS_UG); E.SQ = (bf16_t*)(ws + WS_SQ); E.KKR = (bf16_t*)(ws + WS_KKR); E.V = (bf16_t*)(ws + WS_V);
      E.G = (bf16_t*)(ws + WS_G); E.GS5 = GS5; E.GH = GH; E.LOGF = (float*)(ws + WS_LOGF);
      launch_gemm(mk_gemm(ws + WS_XB, ws + WS_WIN, T_, NIN, D_), E, grid, stream); }
#endif
    DUMP_BF16(12, WS_ORAW_NAIVE, (size_t)T_ * D_);
    DUMP_BF16(1, WS_SQ, (size_t)T_ * HW); DUMP_BF16(2, WS_UG, (size_t)T_ * W5); DUMP_F32(3, WS_LOGF, (size_t)T_ * HW);
#if USE_FAST_S5
    { S5In in{}; in.a_re = a_re; in.a_im = a_im; in.log_dt = log_dt; in.b_re = b_re; in.b_im = b_im; in.c_re = c_re; in.c_im = c_im; in.d = s5d; hipLaunchKernelGGL(k_s5_tab, dim3(64), dim3(512), LDS_BYTES, stream, in, ws + WS_S5TAB);
      S5FArgs a{}; a.UG = (const bf16_t*)(ws + WS_UG); a.tabs = ws + WS_S5TAB; a.Z = (bf16_t*)(ws + WS_Z); hipLaunchKernelGGL(k_s5_fast, dim3(256), dim3(512), LDS_BYTES, stream, a); }
#else
    { S5Args a{}; a.UG = (const bf16_t*)(ws + WS_UG); a.a_re = a_re; a.a_im = a_im; a.log_dt = log_dt; a.b_re = b_re; a.b_im = b_im; a.c_re = c_re; a.c_im = c_im; a.d = s5d; a.Z = (bf16_t*)(ws + WS_Z);
      hipLaunchKernelGGL(k_s5_naive, dim3(256), dim3(64), 0, stream, a); }
#endif
#if USE_FAST_HGRN
#if !USE_FUSED_CUMSUM
    hipLaunchKernelGGL(k_cumsum, dim3(HW / 256, T_ / 64), dim3(256), 0, stream, (const bf16_t*)(ws + WS_SQ), (const float*)(ws + WS_LOGF), (const bf16_t*)(ws + WS_KKR), (bf16_t*)(ws + WS_QD), (bf16_t*)(ws + WS_KD), (float*)(ws + WS_EGL));
#endif
    { HgrnArgs a{}; a.QD = (const bf16_t*)(ws + WS_QD); a.KD = (const bf16_t*)(ws + WS_KD); a.EGL = (const float*)(ws + WS_EGL); a.V = (const bf16_t*)(ws + WS_V); a.ORAW = (bf16_t*)(ws + WS_ORAW); a.SSQH = (float*)(ws + WS_SSQH);
      hipLaunchKernelGGL(k_hgrn_fast, dim3(128), dim3(512), LDS_BYTES, stream, a); }
    hipLaunchKernelGGL(k_oh_fast, dim3(grid), dim3(512), 0, stream, (const bf16_t*)(ws + WS_ORAW), (const float*)(ws + WS_SSQH), (const bf16_t*)(ws + WS_G), norm_g, (bf16_t*)(ws + WS_OH));
#else
    hipLaunchKernelGGL(k_hgrn_naive, dim3(32), dim3(128), 0, stream, (const bf16_t*)(ws + WS_SQ), (const float*)(ws + WS_LOGF), (const bf16_t*)(ws + WS_KKR), (const bf16_t*)(ws + WS_V), (float*)(ws + WS_ORAW_NAIVE));
    hipLaunchKernelGGL(k_oh_naive, dim3(T_ * 8), dim3(64), 0, stream, (const float*)(ws + WS_ORAW_NAIVE), (const bf16_t*)(ws + WS_G), norm_g, (bf16_t*)(ws + WS_OH));
#endif
    if (DBG_STOP == 10) { (void)hipMemcpyAsync(ws + WS_MERGED, GH, (size_t)T_ * D_ * 2, hipMemcpyDeviceToDevice, stream); DUMP_BF16(10, WS_MERGED, (size_t)T_ * D_); }
    if (DBG_STOP == 11) { (void)hipMemcpyAsync(ws + WS_MERGED, GS5, (size_t)T_ * D_ * 2, hipMemcpyDeviceToDevice, stream); DUMP_BF16(11, WS_MERGED, (size_t)T_ * D_); }
    DUMP_BF16(4, WS_Z, (size_t)T_ * W5); DUMP_BF16(5, WS_OH, (size_t)T_ * HW);
    { EpiGlu E{}; E.Z = (const bf16_t*)(ws + WS_Z); E.bias = b_glu; E.ZS = (bf16_t*)(ws + WS_ZS); launch_gemm(mk_gemm(ws + WS_Z, ws + WS_WGLU, T_, W5, W5), E, grid, stream); }
    DUMP_BF16(6, WS_ZS, (size_t)T_ * W5);
    { EpiMerged E{}; E.GS5 = GS5; E.GH = GH; E.MERGED = (bf16_t*)(ws + WS_MERGED);
      pg8::Gemm g = mk_gemm(ws + WS_ZS, ws + WS_WPS5, T_, D_, W5); g.A2 = (const bf16_t*)(ws + WS_OH); g.Bt2 = (const bf16_t*)(ws + WS_WPH);
      hipLaunchKernelGGL(k_gemm_pair, dim3(grid), dim3(512), LDS_BYTES, stream, g, E); }
    DUMP_BF16(7, WS_MERGED, (size_t)T_ * D_);
    { EpiRes E{}; E.XI = x; E.XO = out; E.XBF = (bf16_t*)(ws + WS_X1B); E.ssq = SSQ2; launch_gemm(mk_gemm(ws + WS_MERGED, ws + WS_WOUT, T_, D_, D_), E, grid, stream); }
    if (DBG_STOP == 8) return;
#if USE_FUSED_CONV
    { EpiUpConv E{}; E.ssq = SSQ2; E.cw = conv_w; E.cb = conv_b; E.ACT = (bf16_t*)(ws + WS_ACT); E.RAW = (bf16_t*)(ws + WS_RAW); launch_gemm(mk_gemm(ws + WS_X1B, ws + WS_WUP, T_, NUP, D_), E, grid, stream);
      hipLaunchKernelGGL(k_conv_fixup, dim3(grid), dim3(512), 0, stream, (const bf16_t*)(ws + WS_RAW), conv_w, conv_b, (bf16_t*)(ws + WS_ACT)); }
#else
    for (int q = 0; q < 4; ++q) {
        EpiUpNaive E{}; E.ssq = SSQ2; E.UP = (bf16_t*)(ws + WS_UPQ); E.row0 = q * L_;
        launch_gemm(mk_gemm((bf16_t*)(ws + WS_X1B) + (size_t)q * L_ * D_, ws + WS_WUP, L_, NUP, D_), E, grid, stream);
        hipLaunchKernelGGL(k_conv_naive, dim3(FF / 256, L_), dim3(256), 0, stream, (const bf16_t*)(ws + WS_UPQ), conv_w, conv_b, (bf16_t*)(ws + WS_ACT), q * L_);
    }
    DUMP_BF16(9, WS_ACT, (size_t)T_ * FF);
#endif
    { EpiRes E{}; E.XI = out; E.XO = out; E.XBF = nullptr; E.ssq = SSQ3; launch_gemm(mk_gemm(ws + WS_ACT, ws + WS_WDOWN, T_, D_, FF), E, grid, stream); }
    hipLaunchKernelGGL(k_final, dim3(T_), dim3(256), 0, stream, out, (const float*)SSQ3, ln_final_g);
}
```
